# Optimizing an MI355X kernel written in HIP

```python
import math
import jax, jax.numpy as jnp
from jax import lax
import numpy as np

D_MODEL = 2048
BATCH = 32
SEQ = 256
DEPTH = 2
DEC_BATCH = 4
DEC_SEQ = 1024
PAST_LEN = 256

GRID_W = 64
D_BRANCH = 512
D_MIX = 2048
A_HEADS = 4
A_KV_HEADS = 2
A_HEAD_DIM = 128
A_WINDOW = 128
A_BLOCK = 128
ROPE_THETA = 10000.0
B_HEADS = 8
B_HEAD_DIM = 64
B_GROUPS = 2
B_STATE = 128
B_CONV = 5
B_CHUNK = 128
B_XBC = 1024
POOL_WINDOWS = (2, 4, 8, 16)
N_POOL = 4
POOL_GROUP = 128
D_HEADS = 4
D_HEAD_DIM = 128
NA_KH = 8
NA_KW = 16
PROJ_SIZES = (512, 256, 256, 512,
              1024, 512, 16,
              512, 512,
              512, 512, 512, 512)
D_PROJ = 6160
LN_EPS = 1e-6
NEG_INF = -1e30
F32 = jnp.float32

kernel_name = 'hybrid_diffusion_parallel_heads_step'


def _ln(x):
    xf = x.astype(F32)
    mu = jnp.mean(xf, -1, keepdims=True)
    var = jnp.mean(jnp.square(xf - mu), -1, keepdims=True)
    return ((xf - mu) * lax.rsqrt(var + LN_EPS)).astype(x.dtype)


def _rms(x, w):
    xf = x.astype(F32)
    y = xf * lax.rsqrt(jnp.mean(xf * xf, -1, keepdims=True) + LN_EPS)
    return y.astype(x.dtype) * w


def _split_proj(proj):
    idx = []
    acc = 0
    for s in PROJ_SIZES[:-1]:
        acc += s
        idx.append(acc)
    return jnp.split(proj, idx, axis=-1)


def _grid_pos(T):
    t = jnp.arange(T)
    return (t // GRID_W).astype(F32), (t % GRID_W).astype(F32)


def _rope_axial(x, rows, cols):
    hd = x.shape[-1]
    ax = hd // 2
    nf = ax // 2
    inv = ROPE_THETA ** (-jnp.arange(nf, dtype=F32) / nf)

    def rot(xa, pos):
        ang = pos[:, None] * inv[None, :]
        cos = jnp.cos(ang)[None, :, None, :]
        sin = jnp.sin(ang)[None, :, None, :]
        x1 = xa[..., :nf].astype(F32)
        x2 = xa[..., nf:].astype(F32)
        return jnp.concatenate([x1 * cos - x2 * sin, x1 * sin + x2 * cos], -1)

    return jnp.concatenate([rot(x[..., :ax], rows), rot(x[..., ax:], cols)], -1).astype(x.dtype)


def _ctx_attention(q, k, v, sink):
    Bn, L, H, hd = q.shape
    KV = k.shape[2]
    G = H // KV
    qg = q.reshape(Bn, L, KV, G, hd)
    s = jnp.einsum('blkgd,bmkd->bkglm', qg, k, preferred_element_type=F32) * (hd ** -0.5)
    if sink is not None:
        s_sink = jnp.broadcast_to(sink.astype(F32).reshape(1, KV, G, 1, 1), s.shape[:-1] + (1,))
        s = jnp.concatenate([s, s_sink], -1)
    p = jax.nn.softmax(s, -1)[..., :L].astype(v.dtype)
    o = jnp.einsum('bkglm,bmkd->blkgd', p, v)
    return o.reshape(Bn, L, H * hd)


def _window_attention(q, k, v, k_ctx, v_ctx, sink):
    Bn, T, H, hd = q.shape
    KV = k.shape[2]
    G = H // KV
    nb = T // A_BLOCK
    Lc = k_ctx.shape[1]
    scale = hd ** -0.5
    qb = q.reshape(Bn, nb, A_BLOCK, KV, G, hd)

    def bands(a):
        ap = jnp.pad(a, ((0, 0), (A_BLOCK, A_BLOCK), (0, 0), (0, 0)))
        ap = ap.reshape(Bn, nb + 2, A_BLOCK, KV, hd)
        return jnp.concatenate([ap[:, :-2], ap[:, 1:-1], ap[:, 2:]], axis=2)

    kw = bands(k)
    vw = bands(v)
    s_loc = jnp.einsum('bnqkgd,bnmkd->bnkgqm', qb, kw, preferred_element_type=F32) * scale
    qpos = jnp.arange(nb)[:, None] * A_BLOCK + jnp.arange(A_BLOCK)[None, :]
    kpos = jnp.arange(nb)[:, None] * A_BLOCK - A_BLOCK + jnp.arange(3 * A_BLOCK)[None, :]
    valid = ((jnp.abs(kpos[:, None, :] - qpos[:, :, None]) <= A_WINDOW)
             & (kpos >= 0)[:, None, :] & (kpos < T)[:, None, :])
    s_loc = jnp.where(valid[None, :, None, None], s_loc, NEG_INF)
    s_ctx = jnp.einsum('bnqkgd,blkd->bnkgql', qb, k_ctx, preferred_element_type=F32) * scale
    s_sink = jnp.broadcast_to(sink.astype(F32).reshape(1, 1, KV, G, 1, 1), s_loc.shape[:-1] + (1,))
    p = jax.nn.softmax(jnp.concatenate([s_loc, s_ctx, s_sink], -1), -1)
    nw = 3 * A_BLOCK
    p_loc = p[..., :nw].astype(v.dtype)
    p_ctx = p[..., nw:nw + Lc].astype(v.dtype)
    o = (jnp.einsum('bnkgqm,bnmkd->bnqkgd', p_loc, vw)
         + jnp.einsum('bnkgql,blkd->bnqkgd', p_ctx, v_ctx))
    return o.reshape(Bn, T, H * hd)


def _neighbourhood_attention(q, k, v, k_ctx, v_ctx, rpb):
    Bn, T, H, hd = q.shape
    rows = T // GRID_W
    kh = min(NA_KH, rows)
    Lc = k_ctx.shape[1]
    scale = hd ** -0.5
    r = jnp.arange(rows)
    rs = jnp.clip(r - kh // 2, 0, rows - kh)
    key_rows = rs[:, None] + jnp.arange(kh)[None, :]
    c = jnp.arange(GRID_W)
    cs = jnp.clip(c - NA_KW // 2, 0, GRID_W - NA_KW)
    qg = q.reshape(Bn, rows, GRID_W, H, hd)
    kg = k.reshape(Bn, rows, GRID_W, H, hd)[:, key_rows]
    vg = v.reshape(Bn, rows, GRID_W, H, hd)[:, key_rows]
    s_loc = jnp.einsum('brqhd,brjkhd->brhqjk', qg, kg, preferred_element_type=F32) * scale
    dy = key_rows - r[:, None]
    dx = jnp.clip(c[None, :] - c[:, None], -(NA_KW - 1), NA_KW - 1)
    col_ok = (c[None, :] >= cs[:, None]) & (c[None, :] < cs[:, None] + NA_KW)
    bias = rpb[:, (dy + NA_KH - 1)[:, :, None, None], (dx + NA_KW - 1)[None, None, :, :]]
    bias = bias.transpose(1, 0, 3, 2, 4).astype(F32)
    s_loc = jnp.where(col_ok[:, None, :], s_loc + bias[None], NEG_INF)
    nl = kh * GRID_W
    s_loc = s_loc.reshape(Bn, rows, H, GRID_W, nl)
    s_ctx = jnp.einsum('brqhd,blhd->brhql', qg, k_ctx, preferred_element_type=F32) * scale
    p = jax.nn.softmax(jnp.concatenate([s_loc, s_ctx], -1), -1)
    p_loc = p[..., :nl].reshape(Bn, rows, H, GRID_W, kh, GRID_W).astype(v.dtype)
    p_ctx = p[..., nl:nl + Lc].astype(v.dtype)
    o = (jnp.einsum('brhqjk,brjkhd->brqhd', p_loc, vg)
         + jnp.einsum('brhql,blhd->brqhd', p_ctx, v_ctx))
    return o.reshape(Bn, T, H * hd)


def _pool_branch(p, w_pool, b_pool, pool_scale):
    Bn, T, C = p.shape
    cs = jnp.pad(jnp.cumsum(p.astype(F32), axis=1), ((0, 0), (1, 0), (0, 0)))
    t = jnp.arange(T)
    means = []
    for g, w in enumerate(POOL_WINDOWS):
        lo = jnp.clip(t - w // 2, 0, T)
        hi = jnp.clip(t - w // 2 + w, 0, T)
        sl = cs[..., g * POOL_GROUP:(g + 1) * POOL_GROUP]
        means.append((sl[:, hi] - sl[:, lo]) / (hi - lo).astype(F32)[None, :, None])
    pooled = (jnp.concatenate(means, -1) - p.astype(F32)).astype(p.dtype)
    pg = pooled.reshape(Bn, T, N_POOL, POOL_GROUP)
    out = jnp.einsum('btgc,gcd->btgd', pg, w_pool) + b_pool
    return out.reshape(Bn, T, C) * pool_scale


def _dwconv(x, w, b):
    K, C = w.shape
    y = lax.conv_general_dilated(x, w[:, None, :].astype(x.dtype), (1,), [(K // 2, K // 2)],
                                 dimension_numbers=('NWC', 'WIO', 'NWC'), feature_group_count=C)
    return y + b


def _ssd(x, dt, A, Bm, Cm, h0):
    Bn, T, H, P = x.shape
    G, N = Bm.shape[2], Bm.shape[3]
    Q = B_CHUNK
    nc = T // Q
    rep = H // G
    xc = x.astype(F32).reshape(Bn, nc, Q, H, P)
    Bc = jnp.repeat(Bm.astype(F32), rep, axis=2).reshape(Bn, nc, Q, H, N)
    Cc = jnp.repeat(Cm.astype(F32), rep, axis=2).reshape(Bn, nc, Q, H, N)
    dtc = dt.reshape(Bn, nc, Q, H)
    Lc = jnp.cumsum(dtc * A, axis=2)
    causal = jnp.tril(jnp.ones((Q, Q), bool))
    seg = Lc[:, :, :, None, :] - Lc[:, :, None, :, :]
    decay = jnp.exp(jnp.where(causal[None, None, :, :, None], seg, -jnp.inf))
    cb = jnp.einsum('bcihn,bcjhn->bcijh', Cc, Bc)
    y_intra = jnp.einsum('bcijh,bcjhp->bcihp', cb * decay * dtc[:, :, None, :, :], xc)
    to_end = jnp.exp(Lc[:, :, -1:, :] - Lc) * dtc
    chunk_states = jnp.einsum('bcjhn,bcjhp->bchpn', Bc * to_end[..., None], xc)
    chunk_decay = jnp.exp(Lc[:, :, -1, :])

    def step(h, inp):
        st, dcy = inp
        return dcy[:, :, None, None] * h + st, h

    h_last, h_start = lax.scan(step, h0.astype(F32),
                               (jnp.moveaxis(chunk_states, 1, 0), jnp.moveaxis(chunk_decay, 1, 0)))
    h_start = jnp.moveaxis(h_start, 0, 1)
    y_inter = jnp.einsum('bcihn,bchpn->bcihp', Cc * jnp.exp(Lc)[..., None], h_start)
    y = (y_intra + y_inter).reshape(Bn, T, H, P)
    return y, h_last


def _ssm_branch(xbc, z, dt_raw, h0_f, h0_b, lp):
    Bn, T, _ = xbc.shape
    xbc = jax.nn.silu(_dwconv(xbc, lp['ssm_conv_w'], lp['ssm_conv_b']))
    nx = B_HEADS * B_HEAD_DIM
    xs, Bm, Cm = jnp.split(xbc, [nx, nx + B_GROUPS * B_STATE], axis=-1)
    x = xs.reshape(Bn, T, B_HEADS, B_HEAD_DIM)
    Bm = Bm.reshape(Bn, T, B_GROUPS, B_STATE)
    Cm = Cm.reshape(Bn, T, B_GROUPS, B_STATE)
    dt = jax.nn.softplus(dt_raw.astype(F32).reshape(Bn, T, 2, B_HEADS) + lp['ssm_dt_bias'].astype(F32))
    A = -jnp.exp(lp['ssm_a_log'].astype(F32))
    y_f, h_f = _ssd(x, dt[:, :, 0], A[0], Bm, Cm, h0_f)
    y_b, h_b = _ssd(jnp.flip(x, 1), jnp.flip(dt[:, :, 1], 1), A[1],
                    jnp.flip(Bm, 1), jnp.flip(Cm, 1), h0_b)
    y = y_f + jnp.flip(y_b, 1) + lp['ssm_d'].astype(F32)[:, None] * x.astype(F32)
    y = y.reshape(Bn, T, D_BRANCH).astype(xbc.dtype)
    return _rms(y * jax.nn.silu(z), lp['ssm_norm_w']), h_f.astype(xbc.dtype), h_b.astype(xbc.dtype)


def _modulate_project(x, cvec, lp):
    mod = jax.nn.silu(cvec) @ lp['w_ada'] + lp['b_ada']
    shift, scale, gate = jnp.split(mod[:, None, :], 3, axis=-1)
    u = _ln(x) * (1.0 + scale) + shift
    return _split_proj(u @ lp['w_in']), gate


def _post_norm_residual(x, mixed, gate, lp, alpha):
    out = (mixed @ lp['w_out']) * gate
    return _ln(alpha * x + out) * lp['ln_g'] + lp['ln_b']


def _context_layer(x, c_ctx, lp, alpha):
    Bn, L, _ = x.shape
    parts, gate = _modulate_project(x, c_ctx[None, :], lp)
    qa, ka, va, ga, xbc, z, dt_raw, pc, gc, qd, kd, vd, gd = parts
    qa = qa.reshape(Bn, L, A_HEADS, A_HEAD_DIM)
    ka = ka.reshape(Bn, L, A_KV_HEADS, A_HEAD_DIM)
    va = va.reshape(Bn, L, A_KV_HEADS, A_HEAD_DIM)
    o_a = _ctx_attention(qa, ka, va, lp['attn_sink']) * jax.nn.silu(ga)
    h0 = jnp.zeros((Bn, B_HEADS, B_HEAD_DIM, B_STATE), x.dtype)
    o_b, h_f, h_b = _ssm_branch(xbc, z, dt_raw, h0, h0, lp)
    o_c = _pool_branch(pc, lp['pool_w'], lp['pool_b'], lp['pool_scale']) * jax.nn.silu(gc)
    qd = qd.reshape(Bn, L, D_HEADS, D_HEAD_DIM)
    kd = kd.reshape(Bn, L, D_HEADS, D_HEAD_DIM)
    vd = vd.reshape(Bn, L, D_HEADS, D_HEAD_DIM)
    o_d = _ctx_attention(qd, kd, vd, None) * jax.nn.silu(gd)
    mixed = jnp.concatenate([o_a, o_b, o_c, o_d], -1)
    return _post_norm_residual(x, mixed, gate, lp, alpha), (ka, va, kd, vd, h_f, h_b)


def _latent_layer(x, c, lp, ka_c, va_c, kd_c, vd_c, hf0, hb0, alpha):
    Bn, T, _ = x.shape
    parts, gate = _modulate_project(x, c, lp)
    qa, ka, va, ga, xbc, z, dt_raw, pc, gc, qd, kd, vd, gd = parts
    rows, cols = _grid_pos(T)
    qa = _rope_axial(qa.reshape(Bn, T, A_HEADS, A_HEAD_DIM), rows, cols)
    ka = _rope_axial(ka.reshape(Bn, T, A_KV_HEADS, A_HEAD_DIM), rows, cols)
    va = va.reshape(Bn, T, A_KV_HEADS, A_HEAD_DIM)
    o_a = _window_attention(qa, ka, va, ka_c, va_c, lp['attn_sink']) * jax.nn.silu(ga)
    o_b, _, _ = _ssm_branch(xbc, z, dt_raw, hf0, hb0, lp)
    o_c = _pool_branch(pc, lp['pool_w'], lp['pool_b'], lp['pool_scale']) * jax.nn.silu(gc)
    qd = qd.reshape(Bn, T, D_HEADS, D_HEAD_DIM)
    kd = kd.reshape(Bn, T, D_HEADS, D_HEAD_DIM)
    vd = vd.reshape(Bn, T, D_HEADS, D_HEAD_DIM)
    o_d = _neighbourhood_attention(qd, kd, vd, kd_c, vd_c, lp['na_rpb']) * jax.nn.silu(gd)
    mixed = jnp.concatenate([o_a, o_b, o_c, o_d], -1)
    return _post_norm_residual(x, mixed, gate, lp, alpha)


def setup_inputs(seed: int = 0) -> dict:
    key = jax.random.key(seed)
    ks = jax.random.split(key, 27)

    def nrm(k, shape, s=1.0):
        return jax.random.normal(k, shape, jnp.float32) * s

    out_scale = (8.0 * DEPTH) ** -0.25
    dt_init = jnp.exp(jax.random.uniform(ks[20], (DEPTH, 2, B_HEADS), jnp.float32,
                                         math.log(1e-3), math.log(1e-1)))
    return {
        'x_prompt': nrm(ks[0], (BATCH, SEQ, D_MODEL)),
        'x_sample': nrm(ks[1], (DEC_BATCH, DEC_SEQ, D_MODEL)),
        'cache_attn_k': nrm(ks[2], (DEC_BATCH, DEPTH, PAST_LEN, A_KV_HEADS, A_HEAD_DIM)),
        'cache_attn_v': nrm(ks[3], (DEC_BATCH, DEPTH, PAST_LEN, A_KV_HEADS, A_HEAD_DIM)),
        'cache_na_k': nrm(ks[4], (DEC_BATCH, DEPTH, PAST_LEN, D_HEADS, D_HEAD_DIM)),
        'cache_na_v': nrm(ks[5], (DEC_BATCH, DEPTH, PAST_LEN, D_HEADS, D_HEAD_DIM)),
        'state_ssm_fwd': nrm(ks[6], (DEC_BATCH, DEPTH, B_HEADS, B_HEAD_DIM, B_STATE), 0.5),
        'state_ssm_bwd': nrm(ks[7], (DEC_BATCH, DEPTH, B_HEADS, B_HEAD_DIM, B_STATE), 0.5),
        'c': nrm(ks[8], (DEC_BATCH, D_MODEL)),
        'c_ctx': nrm(ks[9], (D_MODEL,)),
        'w_ada': nrm(ks[10], (DEPTH, D_MODEL, 3 * D_MODEL), 0.5 * D_MODEL ** -0.5),
        'b_ada': nrm(ks[11], (DEPTH, 3 * D_MODEL), 0.02),
        'w_in': nrm(ks[12], (DEPTH, D_MODEL, D_PROJ), D_MODEL ** -0.5),
        'w_out': nrm(ks[13], (DEPTH, D_MIX, D_MODEL), out_scale * D_MIX ** -0.5),
        'ln_g': 1.0 + nrm(ks[14], (DEPTH, D_MODEL), 0.02),
        'ln_b': nrm(ks[15], (DEPTH, D_MODEL), 0.02),
        'attn_sink': nrm(ks[16], (DEPTH, A_HEADS), 0.5),
        'ssm_conv_w': nrm(ks[17], (DEPTH, B_CONV, B_XBC), B_CONV ** -0.5),
        'ssm_conv_b': nrm(ks[18], (DEPTH, B_XBC), 0.02),
        'ssm_a_log': jnp.log(jax.random.uniform(ks[19], (DEPTH, 2, B_HEADS), jnp.float32, 1.0, 16.0)),
        'ssm_dt_bias': dt_init + jnp.log(-jnp.expm1(-dt_init)),
        'ssm_d': 1.0 + nrm(ks[21], (DEPTH, B_HEADS), 0.1),
        'ssm_norm_w': 1.0 + nrm(ks[22], (DEPTH, D_BRANCH), 0.02),
        'pool_w': nrm(ks[23], (DEPTH, N_POOL, POOL_GROUP, POOL_GROUP), POOL_GROUP ** -0.5),
        'pool_b': nrm(ks[24], (DEPTH, N_POOL, POOL_GROUP), 0.02),
        'pool_scale': 1.0 + nrm(ks[25], (DEPTH, D_BRANCH), 0.05),
        'na_rpb': nrm(ks[26], (DEPTH, D_HEADS, 2 * NA_KH - 1, 2 * NA_KW - 1), 0.1),
    }


def reference(x_prompt, x_sample, cache_attn_k, cache_attn_v, cache_na_k, cache_na_v,
              state_ssm_fwd, state_ssm_bwd, c, c_ctx, w_ada, b_ada, w_in, w_out, ln_g, ln_b,
              attn_sink, ssm_conv_w, ssm_conv_b, ssm_a_log, ssm_dt_bias, ssm_d, ssm_norm_w,
              pool_w, pool_b, pool_scale, na_rpb):
    alpha = (2.0 * DEPTH) ** 0.25
    y_prompt = x_prompt
    y_sample = x_sample
    ctx_states = []
    for l in range(DEPTH):
        lp = {'w_ada': w_ada[l], 'b_ada': b_ada[l], 'w_in': w_in[l], 'w_out': w_out[l],
              'ln_g': ln_g[l], 'ln_b': ln_b[l], 'attn_sink': attn_sink[l],
              'ssm_conv_w': ssm_conv_w[l], 'ssm_conv_b': ssm_conv_b[l], 'ssm_a_log': ssm_a_log[l],
              'ssm_dt_bias': ssm_dt_bias[l], 'ssm_d': ssm_d[l], 'ssm_norm_w': ssm_norm_w[l],
              'pool_w': pool_w[l], 'pool_b': pool_b[l], 'pool_scale': pool_scale[l],
              'na_rpb': na_rpb[l]}
        y_prompt, st = _context_layer(y_prompt, c_ctx, lp, alpha)
        ctx_states.append(st)
        y_sample = _latent_layer(y_sample, c, lp, cache_attn_k[:, l], cache_attn_v[:, l],
                                 cache_na_k[:, l], cache_na_v[:, l],
                                 state_ssm_fwd[:, l], state_ssm_bwd[:, l], alpha)
    new_attn_k = jnp.stack([s[0] for s in ctx_states], axis=1)
    new_attn_v = jnp.stack([s[1] for s in ctx_states], axis=1)
    new_na_k = jnp.stack([s[2] for s in ctx_states], axis=1)
    new_na_v = jnp.stack([s[3] for s in ctx_states], axis=1)
    new_ssm_fwd = jnp.stack([s[4] for s in ctx_states], axis=1)
    new_ssm_bwd = jnp.stack([s[5] for s in ctx_states], axis=1)
    return (y_prompt, y_sample, new_attn_k, new_attn_v, new_na_k, new_na_v, new_ssm_fwd, new_ssm_bwd)
```

```cpp
#include <hip/hip_runtime.h>
#include <hip/hip_fp16.h>
#include <hip/hip_cooperative_groups.h>
#include <cstdio>
namespace cg = cooperative_groups;

typedef _Float16 h16;
typedef __attribute__((ext_vector_type(8))) _Float16 h16x8;
typedef __attribute__((ext_vector_type(4))) _Float16 h16x4;
typedef __attribute__((ext_vector_type(4))) float f32x4;

#define DM 2048
#define MTOK 12288
#define MCTX 8192
#define DPROJ 6160
#define NPAD 6272
#define NTHREADS 256

#define C_QA 0
#define C_KA 512
#define C_VA 768
#define C_GA 1024
#define C_XBC 1536
#define C_Z 2560
#define C_DT 3072
#define C_PC 3088
#define C_GC 3600
#define C_QD 4112
#define C_KD 4624
#define C_VD 5136
#define C_GD 5648

#define O_Y 0
#define O_NAK 25165824
#define O_NAV 29360128
#define O_NNK 33554432
#define O_NNV 41943040
#define O_SF 50331648
#define O_SB 54525952

constexpr size_t SZ_WTIN = 2ull * NPAD * DM * 2;
constexpr size_t SZ_WTOUT = 2ull * DM * DM * 2;
constexpr size_t SZ_POOLWT = 2ull * 4 * 128 * 128 * 2;
constexpr size_t SZ_MOD = 2ull * 5 * 6144 * 4;
constexpr size_t SZ_BAR = 14080;
constexpr size_t SZ_ROPE = 1024ull * 64 * 8;
constexpr size_t SZ_KCA = 4ull * 2 * 256 * 256 * 2;
constexpr size_t SZ_KCD = 4ull * 2 * 256 * 512 * 2;
constexpr size_t SZ_VTAC = SZ_KCA;
constexpr size_t SZ_VTDC = SZ_KCD;
constexpr size_t SZ_U = (size_t)MTOK * DM * 2;
constexpr size_t SZ_PROJ = (size_t)MTOK * DPROJ * 2;
constexpr size_t SZ_VTA_CTX = 32ull * 2 * 128 * 256 * 2;
constexpr size_t SZ_VTA_LAT = 4ull * 2 * 128 * 1024 * 2;
constexpr size_t SZ_VTD_CTX = 32ull * 4 * 128 * 256 * 2;
constexpr size_t SZ_VTD_LAT = 4ull * 4 * 128 * 1024 * 2;
constexpr size_t SZ_YBUF = (size_t)MTOK * 512 * 4;
constexpr size_t SZ_STATES = 96ull * 8 * 2 * 8192 * 2;
constexpr size_t SZ_CDEC = 96ull * 8 * 2 * 4;
constexpr size_t SZ_HS = 4ull * 8 * 8 * 2 * 8192 * 2;

constexpr size_t OFF_WTIN = 0;
constexpr size_t OFF_WTOUT = OFF_WTIN + SZ_WTIN;
constexpr size_t OFF_POOLWT = OFF_WTOUT + SZ_WTOUT;
constexpr size_t OFF_MOD = OFF_POOLWT + SZ_POOLWT;
constexpr size_t OFF_BAR = OFF_MOD + SZ_MOD;
constexpr size_t OFF_ROPE = OFF_BAR + SZ_BAR;
constexpr size_t OFF_KCA = OFF_ROPE + SZ_ROPE;
constexpr size_t OFF_KCD = OFF_KCA + SZ_KCA;
constexpr size_t OFF_VTAC = OFF_KCD + SZ_KCD;
constexpr size_t OFF_VTDC = OFF_VTAC + SZ_VTAC;
constexpr size_t OFF_U = OFF_VTDC + SZ_VTDC;
constexpr size_t OFF_PROJ = OFF_U + SZ_U;
constexpr size_t OFF_VTA_CTX = OFF_PROJ + SZ_PROJ;
constexpr size_t OFF_VTA_LAT = OFF_VTA_CTX + SZ_VTA_CTX;
constexpr size_t OFF_VTD_CTX = OFF_VTA_LAT + SZ_VTA_LAT;
constexpr size_t OFF_VTD_LAT = OFF_VTD_CTX + SZ_VTD_CTX;
constexpr size_t OFF_YBUF = OFF_VTD_LAT + SZ_VTD_LAT;
constexpr size_t OFF_STATES = OFF_YBUF + SZ_YBUF;
constexpr size_t OFF_CDEC = OFF_STATES + SZ_STATES;
constexpr size_t OFF_HS = OFF_CDEC + SZ_CDEC + 256;
constexpr size_t SZ_XBCN = (size_t)MTOK * 512 * 2;
constexpr size_t SZ_XT = (size_t)MTOK * 512 * 2;
constexpr size_t SZ_BT = (size_t)MTOK * 256 * 2;
constexpr size_t SZ_DTL = 96ull * 16 * 128 * 4;
constexpr size_t OFF_XBCN = OFF_HS + SZ_HS;
constexpr size_t OFF_XT = OFF_XBCN + SZ_XBCN;
constexpr size_t OFF_BT = OFF_XT + SZ_XT;
constexpr size_t OFF_DT = OFF_BT + SZ_BT;
constexpr size_t OFF_LL = OFF_DT + SZ_DTL;
constexpr size_t WS_NEED = OFF_LL + SZ_DTL + 256;

struct Params {
  const float* in[27];
  float* out;
  char* ws;
  int phase_lo, phase_hi;
};

enum { I_XP = 0, I_XS, I_CAK, I_CAV, I_CNK, I_CNV, I_SF, I_SB, I_C, I_CCTX, I_WADA, I_BADA, I_WIN, I_WOUT,
       I_LNG, I_LNB, I_SINK, I_CONVW, I_CONVB, I_ALOG, I_DTB, I_SSMD, I_NORMW, I_POOLW, I_POOLB, I_POOLS, I_RPB };

#define LDS_BYTES 73728

__device__ __forceinline__ float silu_f(float x) { return x / (1.f + __expf(-x)); }
__device__ __forceinline__ f32x4 mfma16(h16x8 a, h16x8 b, f32x4 c) {
  return __builtin_amdgcn_mfma_f32_16x16x32_f16(a, b, c, 0, 0, 0);
}
__device__ __forceinline__ h16x8 pack8(f32x4 a, f32x4 b) {
  h16x8 r;
  r[0] = (h16)a[0]; r[1] = (h16)a[1]; r[2] = (h16)a[2]; r[3] = (h16)a[3];
  r[4] = (h16)b[0]; r[5] = (h16)b[1]; r[6] = (h16)b[2]; r[7] = (h16)b[3];
  return r;
}
__device__ __forceinline__ h16x4 pack4(f32x4 a) {
  h16x4 r;
  r[0] = (h16)a[0]; r[1] = (h16)a[1]; r[2] = (h16)a[2]; r[3] = (h16)a[3];
  return r;
}
__device__ __forceinline__ h16x8 read_split(const h16* p0, const h16* p1) {
  h16x4 a = *(const h16x4*)p0;
  h16x4 b = *(const h16x4*)p1;
  return __builtin_shufflevector(a, b, 0, 1, 2, 3, 4, 5, 6, 7);
}
__device__ __forceinline__ float wave_sum(float v) {
#pragma unroll
  for (int o = 32; o > 0; o >>= 1) v += __shfl_xor(v, o);
  return v;
}
__device__ __forceinline__ int row_cond(int row) { return row < MCTX ? 0 : 1 + ((row - MCTX) >> 10); }

__device__ __forceinline__ void transpose_tile(const float* __restrict__ src, int sstride, int cvalid, h16* __restrict__ dst,
                               int dstride, int r0, int c0, char* lds) {
  float* tile = (float*)lds;
  int tid = threadIdx.x;
  asm volatile("" : "+v"(tid));
  int c = tid & 63, rr = tid >> 6;
#pragma unroll
  for (int i = 0; i < 16; ++i) {
    int r = i * 4 + rr;
    float v = 0.f;
    if (c0 + c < cvalid) v = src[(size_t)(r0 + r) * sstride + c0 + c];
    tile[r * 65 + c] = v;
  }
  __syncthreads();
  int cc = tid >> 2, rq = (tid & 3) * 16;
  h16x8 o0, o1;
#pragma unroll
  for (int k = 0; k < 8; ++k) {
    o0[k] = (h16)tile[(rq + k) * 65 + cc];
    o1[k] = (h16)tile[(rq + 8 + k) * 65 + cc];
  }
  h16* d = dst + (size_t)(c0 + cc) * dstride + r0 + rq;
  *(h16x8*)d = o0;
  *(h16x8*)(d + 8) = o1;
  __syncthreads();
}

__device__ __forceinline__ void transpose_wide(const float* __restrict__ src, int sstride, int cvalid, h16* __restrict__ dst,
                                               int dstride, int nrows_dst, int r0, int c0, char* lds) {
  float* tile = (float*)lds;
  int tid = threadIdx.x;
  asm volatile("" : "+v"(tid));
  const int lane = tid & 63, rr = tid >> 6;
  const int c4 = lane * 4;
  float4 v[16];
#pragma unroll
  for (int i = 0; i < 16; ++i) {
    int r = rr + 4 * i;
    v[i] = make_float4(0.f, 0.f, 0.f, 0.f);
    if (c0 + c4 < cvalid) v[i] = *(const float4*)(src + (size_t)(r0 + r) * sstride + c0 + c4);
  }
#pragma unroll
  for (int i = 0; i < 16; ++i) *(float4*)(tile + (rr + 4 * i) * 260 + c4) = v[i];
  __syncthreads();
  if (c0 + tid < nrows_dst) {
    h16* d = dst + (size_t)(c0 + tid) * dstride + r0;
#pragma unroll
    for (int q = 0; q < 8; ++q) {
      h16x8 o;
#pragma unroll
      for (int e = 0; e < 8; ++e) o[e] = (h16)tile[(q * 8 + e) * 260 + tid];
      *(h16x8*)(d + q * 8) = o;
    }
  }
  __syncthreads();
}

__device__ __forceinline__ void ada_unit(const Params& P, int u, char* lds) {
  int kc = u & 15;
  int cgp = (u >> 4) % 24;
  int l = u / 384;
  int tid = threadIdx.x;
  asm volatile("" : "+v"(tid));
  int lane = tid & 63, wave = tid >> 6;
  const float* W = P.in[I_WADA] + (size_t)l * DM * 6144;
  int col = cgp * 256 + lane * 4;
  int k0 = kc * 128 + wave * 32;
  float acc[5][4];
#pragma unroll
  for (int c = 0; c < 5; ++c)
#pragma unroll
    for (int e = 0; e < 4; ++e) acc[c][e] = 0.f;
  const float* cctx = P.in[I_CCTX];
  const float* cl = P.in[I_C];
#pragma unroll 8
  for (int k = k0; k < k0 + 32; ++k) {
    float4 w = *(const float4*)(W + (size_t)k * 6144 + col);
    float s[5];
    s[0] = silu_f(cctx[k]);
#pragma unroll
    for (int c = 0; c < 4; ++c) s[c + 1] = silu_f(cl[c * DM + k]);
#pragma unroll
    for (int c = 0; c < 5; ++c) {
      acc[c][0] += s[c] * w.x; acc[c][1] += s[c] * w.y; acc[c][2] += s[c] * w.z; acc[c][3] += s[c] * w.w;
    }
  }
  float* red = (float*)lds;
#pragma unroll
  for (int c = 0; c < 5; ++c)
#pragma unroll
    for (int e = 0; e < 4; ++e) red[(wave * 5 + c) * 256 + lane * 4 + e] = acc[c][e];
  __syncthreads();
  float* mod = (float*)(P.ws + OFF_MOD) + (size_t)l * 5 * 6144;
  int ocol = cgp * 256 + tid;
  float bias = (kc == 0) ? P.in[I_BADA][l * 6144 + ocol] : 0.f;
#pragma unroll
  for (int c = 0; c < 5; ++c) {
    float s = red[(0 * 5 + c) * 256 + tid] + red[(1 * 5 + c) * 256 + tid] + red[(2 * 5 + c) * 256 + tid] +
              red[(3 * 5 + c) * 256 + tid];
    atomicAdd(mod + c * 6144 + ocol, s + bias);
  }
  __syncthreads();
}

__device__ __forceinline__ void prep_unit(const Params& P, int v, char* lds) {
  const int U_ADA = 768, U_WIN = 2 * 32 * 25, U_WOUT = 2 * 32 * 8, U_POOL = 32, U_VTA = 128, U_VTD = 256,
            U_KCA = 128, U_KCD = 256;
  int tid = threadIdx.x;
  asm volatile("" : "+v"(tid));
  {
    if (v < U_ADA) { ada_unit(P, v, lds); return; }
    v -= U_ADA;
    if (v < U_WIN) {
      int l = v / (32 * 25), r = v % (32 * 25);
      int kt = r / 25, ng = r % 25;
      transpose_wide(P.in[I_WIN] + (size_t)l * DM * DPROJ, DPROJ, DPROJ, (h16*)(P.ws + OFF_WTIN) + (size_t)l * NPAD * DM, DM,
                     NPAD, kt * 64, ng * 256, lds);
      return;
    }
    v -= U_WIN;
    if (v < U_WOUT) {
      int l = v / 256, r = v % 256;
      int kt = r / 8, ng = r % 8;
      transpose_wide(P.in[I_WOUT] + (size_t)l * DM * DM, DM, DM, (h16*)(P.ws + OFF_WTOUT) + (size_t)l * DM * DM, DM, DM,
                     kt * 64, ng * 256, lds);
      return;
    }
    v -= U_WOUT;
    if (v < U_POOL) {
      int lg = v >> 2, r = v & 3;
      transpose_tile(P.in[I_POOLW] + (size_t)lg * 128 * 128, 128, 128, (h16*)(P.ws + OFF_POOLWT) + (size_t)lg * 128 * 128,
                     128, (r >> 1) * 64, (r & 1) * 64, lds);
      return;
    }
    v -= U_POOL;
    if (v < U_VTA) {
      int bl = v >> 4, r = v & 15;
      transpose_tile(P.in[I_CAV] + (size_t)bl * 256 * 256, 256, 256, (h16*)(P.ws + OFF_VTAC) + (size_t)bl * 256 * 256, 256,
                     (r >> 2) * 64, (r & 3) * 64, lds);
      return;
    }
    v -= U_VTA;
    if (v < U_VTD) {
      int bl = v >> 5, r = v & 31;
      transpose_tile(P.in[I_CNV] + (size_t)bl * 256 * 512, 512, 512, (h16*)(P.ws + OFF_VTDC) + (size_t)bl * 512 * 256, 256,
                     (r >> 3) * 64, (r & 7) * 64, lds);
      return;
    }
    v -= U_VTD;
    if (v < U_KCA + U_KCD) {
      const float* src;
      h16* dst;
      if (v < U_KCA) { src = P.in[I_CAK]; dst = (h16*)(P.ws + OFF_KCA); }
      else { v -= U_KCA; src = P.in[I_CNK]; dst = (h16*)(P.ws + OFF_KCD); }
      size_t base = (size_t)v * 4096;
#pragma unroll
      for (int i = 0; i < 4; ++i) {
        size_t idx = base + (size_t)(i * 256 + tid) * 4;
        float4 x = *(const float4*)(src + idx);
        h16x4 o;
        o[0] = (h16)x.x; o[1] = (h16)x.y; o[2] = (h16)x.z; o[3] = (h16)x.w;
        *(h16x4*)(dst + idx) = o;
      }
      return;
    }
    v -= U_KCA + U_KCD;
    {
      float2* rope = (float2*)(P.ws + OFF_ROPE);
#pragma unroll
      for (int e = 0; e < 4; ++e) {
        int idx = v * 1024 + e * 256 + tid;
        int t = idx >> 6, j = idx & 63;
        int half = j >> 5, f = j & 31;
        float inv = powf(10000.f, -(float)f / 32.f);
        float pos = half ? (float)(t & 63) : (float)(t >> 6);
        float ang = pos * inv;
        rope[idx] = make_float2(cosf(ang), sinf(ang));
      }
    }
  }
}
__device__ __forceinline__ void prep_phase(const Params& P, char* lds) {
  for (int i = blockIdx.x; i < 384; i += gridDim.x) prep_unit(P, i, lds);
}
#define PREP_REST (384 + 1600 + 512 + 32 + 128 + 256 + 128 + 256 + 64)
__device__ __forceinline__ void prep_rest_phase(const Params& P, char* lds) {
  for (int i = blockIdx.x; i < PREP_REST; i += gridDim.x) prep_unit(P, 384 + i, lds);
}

__device__ __forceinline__ void row_phase(const Params& P, int l) {
  constexpr int RPW = 3;
  int tid = threadIdx.x;
  asm volatile("" : "+v"(tid));
  int lane = tid & 63, wave = tid >> 6;
  float* y = P.out + O_Y;
  h16* U = (h16*)(P.ws + OFF_U);
  const int nwaves = gridDim.x * 4;
  for (int grp = blockIdx.x * 4 + wave; grp * RPW < MTOK; grp += nwaves) {
    float4 x[RPW][8];
#pragma unroll
    for (int r = 0; r < RPW; ++r) {
      int row = grp * RPW + r;
      const float* src;
      if (l == 0) src = (row < MCTX) ? P.in[I_XP] + (size_t)row * DM : P.in[I_XS] + (size_t)(row - MCTX) * DM;
      else src = y + (size_t)row * DM;
#pragma unroll
      for (int i = 0; i < 8; ++i) x[r][i] = *(const float4*)(src + (i * 64 + lane) * 4);
    }
    if (l > 0) {
      const float* g = P.in[I_LNG] + (l - 1) * DM;
      const float* bb = P.in[I_LNB] + (l - 1) * DM;
#pragma unroll
      for (int r = 0; r < RPW; ++r) {
        int row = grp * RPW + r;
        float s = 0.f;
#pragma unroll
        for (int i = 0; i < 8; ++i) s += x[r][i].x + x[r][i].y + x[r][i].z + x[r][i].w;
        float mu = wave_sum(s) * (1.f / DM);
        float q = 0.f;
#pragma unroll
        for (int i = 0; i < 8; ++i) {
          float a = x[r][i].x - mu, b = x[r][i].y - mu, c = x[r][i].z - mu, d = x[r][i].w - mu;
          q += a * a + b * b + c * c + d * d;
        }
        float rstd = rsqrtf(wave_sum(q) * (1.f / DM) + 1e-6f);
#pragma unroll
        for (int i = 0; i < 8; ++i) {
          int c0 = (i * 64 + lane) * 4;
          float4 gg = *(const float4*)(g + c0), b4 = *(const float4*)(bb + c0);
          x[r][i].x = (x[r][i].x - mu) * rstd * gg.x + b4.x;
          x[r][i].y = (x[r][i].y - mu) * rstd * gg.y + b4.y;
          x[r][i].z = (x[r][i].z - mu) * rstd * gg.z + b4.z;
          x[r][i].w = (x[r][i].w - mu) * rstd * gg.w + b4.w;
          *(float4*)(y + (size_t)row * DM + c0) = x[r][i];
        }
      }
    }
    if (l < 2) {
#pragma unroll
      for (int r = 0; r < RPW; ++r) {
        int row = grp * RPW + r;
        float s = 0.f;
#pragma unroll
        for (int i = 0; i < 8; ++i) s += x[r][i].x + x[r][i].y + x[r][i].z + x[r][i].w;
        float mu = wave_sum(s) * (1.f / DM);
        float q = 0.f;
#pragma unroll
        for (int i = 0; i < 8; ++i) {
          float a = x[r][i].x - mu, b = x[r][i].y - mu, c = x[r][i].z - mu, d = x[r][i].w - mu;
          q += a * a + b * b + c * c + d * d;
        }
        float rstd = rsqrtf(wave_sum(q) * (1.f / DM) + 1e-6f);
        const float* mod = (const float*)(P.ws + OFF_MOD) + ((size_t)l * 5 + row_cond(row)) * 6144;
#pragma unroll
        for (int i = 0; i < 8; ++i) {
          int c0 = (i * 64 + lane) * 4;
          float4 sh = *(const float4*)(mod + c0), sc = *(const float4*)(mod + 2048 + c0);
          h16x4 o;
          o[0] = (h16)((x[r][i].x - mu) * rstd * (1.f + sc.x) + sh.x);
          o[1] = (h16)((x[r][i].y - mu) * rstd * (1.f + sc.y) + sh.y);
          o[2] = (h16)((x[r][i].z - mu) * rstd * (1.f + sc.z) + sh.z);
          o[3] = (h16)((x[r][i].w - mu) * rstd * (1.f + sc.w) + sh.w);
          *(h16x4*)(U + (size_t)row * DM + c0) = o;
        }
      }
    }
  }
}

#define GLS 64
typedef __attribute__((ext_vector_type(4))) unsigned u32x4;
struct GStage { u32x4 w0, w1, w2, w3, u0, u1, u2, u3; };
__device__ __forceinline__ void g_load(GStage& S, const h16* gW, const h16* gU, int kt) {
  S.w0 = *(const u32x4*)(gW + (size_t)0 * 32 * DM + kt * 64);
  S.w1 = *(const u32x4*)(gW + (size_t)1 * 32 * DM + kt * 64);
  S.w2 = *(const u32x4*)(gW + (size_t)2 * 32 * DM + kt * 64);
  S.w3 = *(const u32x4*)(gW + (size_t)3 * 32 * DM + kt * 64);
  S.u0 = *(const u32x4*)(gU + (size_t)0 * 32 * DM + kt * 64);
  S.u1 = *(const u32x4*)(gU + (size_t)1 * 32 * DM + kt * 64);
  S.u2 = *(const u32x4*)(gU + (size_t)2 * 32 * DM + kt * 64);
  S.u3 = *(const u32x4*)(gU + (size_t)3 * 32 * DM + kt * 64);
}
__device__ __forceinline__ void g_store(const GStage& S, h16* sW, h16* sU, int buf, int ld_row, int ld_k) {
  const int pc = ((ld_k >> 3) ^ ((ld_row >> 1) & 7)) * 8;
  h16* w = sW + buf * 128 * GLS + ld_row * GLS + pc;
  h16* u = sU + buf * 128 * GLS + ld_row * GLS + pc;
  *(u32x4*)(w + 0 * 32 * GLS) = S.w0;
  *(u32x4*)(w + 1 * 32 * GLS) = S.w1;
  *(u32x4*)(w + 2 * 32 * GLS) = S.w2;
  *(u32x4*)(w + 3 * 32 * GLS) = S.w3;
  *(u32x4*)(u + 0 * 32 * GLS) = S.u0;
  *(u32x4*)(u + 1 * 32 * GLS) = S.u1;
  *(u32x4*)(u + 2 * 32 * GLS) = S.u2;
  *(u32x4*)(u + 3 * 32 * GLS) = S.u3;
}
__device__ __forceinline__ void g_compute(f32x4 (&acc)[4][4], const h16* cW, const h16* cU, int sw0) {
#pragma unroll
  for (int ks = 0; ks < 2; ++ks) {
    const int off = sw0 ^ (ks * 32);
    h16x8 a[4];
#pragma unroll
    for (int i = 0; i < 4; ++i) a[i] = *(const h16x8*)(cW + i * 16 * GLS + off);
    h16x8 bc = *(const h16x8*)(cU + off);
#pragma unroll
    for (int j = 0; j < 4; ++j) {
      h16x8 bn = bc;
      if (j < 3) bn = *(const h16x8*)(cU + (j + 1) * 16 * GLS + off);
      __builtin_amdgcn_sched_barrier(0);
#pragma unroll
      for (int i = 0; i < 4; ++i) acc[i][j] = mfma16(a[i], bc, acc[i][j]);
      __builtin_amdgcn_sched_barrier(0);
      bc = bn;
    }
  }
}
template <int EPI>
__device__ __forceinline__ void gemm_phase(const Params& P, int l, char* lds) {
  const int xcd = blockIdx.x & 7, lj = blockIdx.x >> 3;
  const int nchunk8 = (int)(gridDim.x >> 3);
  const h16* Wt = (EPI == 0) ? (const h16*)(P.ws + OFF_WTIN) + (size_t)l * NPAD * DM
                             : (const h16*)(P.ws + OFF_WTOUT) + (size_t)l * DM * DM;
  const h16* A = (const h16*)(P.ws + OFF_U);
  const int NTn = (EPI == 0) ? NPAD / 128 : DM / 128;
  const int ntiles = NTn * (MTOK / 128);
  h16* sW = (h16*)lds;
  h16* sU = sW + 2 * 128 * GLS;
  int tid = threadIdx.x;
  asm volatile("" : "+v"(tid));
  int lane = tid & 63, wave = tid >> 6;
  int wn = wave & 1, wm = wave >> 1;
  int lr = lane & 15, quad = lane >> 4;
  int ld_row = tid >> 3, ld_k = (tid & 7) * 8;
  const int sw0 = (quad ^ ((lr >> 1) & 7)) * 8;
  const int RN = (EPI == 0) ? 7 : 8;
  const int nrn = NTn / RN;
  for (int it = 0;; ++it) {
    int tile = (it * 8 + xcd) * nchunk8 + lj;
    if (tile >= ntiles) break;
    int rect = tile / (8 * RN), within = tile % (8 * RN);
    int mt = (rect / nrn) * 8 + (within & 7), nt = (rect % nrn) * RN + (within >> 3);
    int n0 = nt * 128, m0 = mt * 128;
    const h16* gW = Wt + (size_t)(n0 + ld_row) * DM + ld_k;
    const h16* gU = A + (size_t)(m0 + ld_row) * DM + ld_k;
    GStage stA, stB;
    f32x4 acc[4][4];
#pragma unroll
    for (int i = 0; i < 4; ++i)
#pragma unroll
      for (int j = 0; j < 4; ++j) acc[i][j] = (f32x4){0.f, 0.f, 0.f, 0.f};
    g_load(stB, gW, gU, 0);
    g_load(stA, gW, gU, 1);
    g_store(stB, sW, sU, 0, ld_row, ld_k);
    g_load(stB, gW, gU, 2);
    __syncthreads();
    for (int kt = 0; kt < 32; kt += 2) {
      g_store(stA, sW, sU, 1, ld_row, ld_k);
      g_load(stA, gW, gU, min(kt + 3, 31));
      __builtin_amdgcn_s_setprio(1);
      g_compute(acc, sW + (wn * 64 + lr) * GLS, sU + (wm * 64 + lr) * GLS, sw0);
      __builtin_amdgcn_s_setprio(0);
      __syncthreads();
      g_store(stB, sW, sU, 0, ld_row, ld_k);
      g_load(stB, gW, gU, min(kt + 4, 31));
      __builtin_amdgcn_s_setprio(1);
      g_compute(acc, sW + 128 * GLS + (wn * 64 + lr) * GLS, sU + 128 * GLS + (wm * 64 + lr) * GLS, sw0);
      __builtin_amdgcn_s_setprio(0);
      __syncthreads();
    }
    if (EPI == 0) {
      bool lat = (m0 >= MCTX);
      if (lat && n0 < C_VA) {
        const float2* rope = (const float2*)(P.ws + OFF_ROPE);
#pragma unroll
        for (int j = 0; j < 4; ++j) {
          int m = m0 + wm * 64 + j * 16 + lr;
          int t = (m - MCTX) & 1023;
#pragma unroll
          for (int i = 0; i < 2; ++i)
#pragma unroll
            for (int jj = 0; jj < 4; ++jj) {
              float2 cs = rope[t * 64 + wn * 32 + i * 16 + quad * 4 + jj];
              float x1 = acc[i][j][jj], x2 = acc[i + 2][j][jj];
              acc[i][j][jj] = x1 * cs.x - x2 * cs.y;
              acc[i + 2][j][jj] = x1 * cs.y + x2 * cs.x;
            }
        }
      }
      h16* proj = (h16*)(P.ws + OFF_PROJ);
#pragma unroll
      for (int i = 0; i < 4; ++i) {
        int n = n0 + wn * 64 + i * 16 + quad * 4;
        if (n >= DPROJ) continue;
        bool isVa = (n >= C_VA && n < C_GA);
        bool isVd = (n >= C_VD && n < C_GD);
#pragma unroll
        for (int j = 0; j < 4; ++j) {
          int m = m0 + wm * 64 + j * 16 + lr;
          f32x4 v = acc[i][j];
          if (isVa || isVd) {
            int nn = isVa ? n - C_VA : n - C_VD;
            h16* dst;
            int T, t;
            if (!lat) {
              int b = m >> 8; t = m & 255; T = 256;
              dst = isVa ? (h16*)(P.ws + OFF_VTA_CTX) + ((size_t)b * 256 + nn) * 256
                         : (h16*)(P.ws + OFF_VTD_CTX) + ((size_t)b * 512 + nn) * 256;
            } else {
              int b = (m - MCTX) >> 10; t = (m - MCTX) & 1023; T = 1024;
              dst = isVa ? (h16*)(P.ws + OFF_VTA_LAT) + ((size_t)b * 256 + nn) * 1024
                         : (h16*)(P.ws + OFF_VTD_LAT) + ((size_t)b * 512 + nn) * 1024;
            }
#pragma unroll
            for (int jj = 0; jj < 4; ++jj) dst[(size_t)jj * T + t] = (h16)v[jj];
          } else {
            *(h16x4*)(proj + (size_t)m * DPROJ + n) = pack4(v);
          }
          if (!lat) {
            int b = m >> 8, t = m & 255;
            size_t r = ((size_t)(b * 2 + l) * 256 + t);
            float* o = nullptr;
            if (n >= C_KA && n < C_VA) o = P.out + O_NAK + r * 256 + (n - C_KA);
            else if (isVa) o = P.out + O_NAV + r * 256 + (n - C_VA);
            else if (n >= C_KD && n < C_VD) o = P.out + O_NNK + r * 512 + (n - C_KD);
            else if (isVd) o = P.out + O_NNV + r * 512 + (n - C_VD);
            if (o) *(float4*)o = make_float4(v[0], v[1], v[2], v[3]);
          }
        }
      }
    } else {
      const float alpha = 1.41421356237f;
      float* y = P.out + O_Y;
#pragma unroll
      for (int i = 0; i < 4; ++i) {
        int n = n0 + wn * 64 + i * 16 + quad * 4;
#pragma unroll
        for (int j = 0; j < 4; ++j) {
          int m = m0 + wm * 64 + j * 16 + lr;
          const float* xs;
          if (l == 0) xs = (m < MCTX) ? P.in[I_XP] + (size_t)m * DM : P.in[I_XS] + (size_t)(m - MCTX) * DM;
          else xs = y + (size_t)m * DM;
          float4 xv = *(const float4*)(xs + n);
          float4 g = *(const float4*)((const float*)(P.ws + OFF_MOD) + ((size_t)l * 5 + row_cond(m)) * 6144 + 4096 + n);
          f32x4 v = acc[i][j];
          float4 o = make_float4(alpha * xv.x + g.x * v[0], alpha * xv.y + g.y * v[1], alpha * xv.z + g.z * v[2],
                                 alpha * xv.w + g.w * v[3]);
          *(float4*)(y + (size_t)m * DM + n) = o;
        }
      }
    }
  }
}

struct JStage { u32x4 w0, w1, w2, w3, u0, u1, u2, u3, u4, u5, u6, u7; };
__device__ __forceinline__ u32x4 ldg_so(const h16* ubase, unsigned boff) {
  return *(const u32x4*)((const char*)ubase + boff);
}
__device__ __forceinline__ void j_load(JStage& S, const h16* Wk, const h16* Uk, unsigned voff) {
  S.w0 = ldg_so(Wk, voff + 0u * 131072u);
  S.w1 = ldg_so(Wk, voff + 1u * 131072u);
  S.w2 = ldg_so(Wk, voff + 2u * 131072u);
  S.w3 = ldg_so(Wk, voff + 3u * 131072u);
  S.u0 = ldg_so(Uk, voff + 0u * 131072u);
  S.u1 = ldg_so(Uk, voff + 1u * 131072u);
  S.u2 = ldg_so(Uk, voff + 2u * 131072u);
  S.u3 = ldg_so(Uk, voff + 3u * 131072u);
  S.u4 = ldg_so(Uk, voff + 4u * 131072u);
  S.u5 = ldg_so(Uk, voff + 5u * 131072u);
  S.u6 = ldg_so(Uk, voff + 6u * 131072u);
  S.u7 = ldg_so(Uk, voff + 7u * 131072u);
}
__device__ __forceinline__ void j_store(const JStage& S, h16* sW, h16* sU, int ld_row, int pc) {
  h16* w = sW + ld_row * 64 + pc;
  h16* u = sU + ld_row * 64 + pc;
  *(u32x4*)(w + 0 * 2048) = S.w0;
  *(u32x4*)(w + 1 * 2048) = S.w1;
  *(u32x4*)(w + 2 * 2048) = S.w2;
  *(u32x4*)(w + 3 * 2048) = S.w3;
  *(u32x4*)(u + 0 * 2048) = S.u0;
  *(u32x4*)(u + 1 * 2048) = S.u1;
  *(u32x4*)(u + 2 * 2048) = S.u2;
  *(u32x4*)(u + 3 * 2048) = S.u3;
  *(u32x4*)(u + 4 * 2048) = S.u4;
  *(u32x4*)(u + 5 * 2048) = S.u5;
  *(u32x4*)(u + 6 * 2048) = S.u6;
  *(u32x4*)(u + 7 * 2048) = S.u7;
}
__device__ __forceinline__ void j_compute(f32x4 (&acc)[4][8], const h16* cW, const h16* cU, int sw0) {
#pragma unroll
  for (int ks = 0; ks < 2; ++ks) {
    const int off = sw0 ^ (ks * 32);
    h16x8 a[4];
#pragma unroll
    for (int i = 0; i < 4; ++i) a[i] = *(const h16x8*)(cW + i * 16 * 64 + off);
    h16x8 b0 = *(const h16x8*)(cU + off);
    h16x8 b1 = *(const h16x8*)(cU + 1 * 16 * 64 + off);
    h16x8 b2 = *(const h16x8*)(cU + 2 * 16 * 64 + off);
#pragma unroll
    for (int j = 0; j < 8; ++j) {
      h16x8 b3 = b2;
      if (j < 5) b3 = *(const h16x8*)(cU + (j + 3) * 16 * 64 + off);
      __builtin_amdgcn_sched_barrier(0);
#pragma unroll
      for (int i = 0; i < 4; ++i) acc[i][j] = mfma16(a[i], b0, acc[i][j]);
      __builtin_amdgcn_sched_barrier(0);
      b0 = b1;
      b1 = b2;
      b2 = b3;
    }
  }
}
__device__ __forceinline__ void gemm_in_phase(const Params& P, int l, char* lds) {
  const int xcd = blockIdx.x & 7, lj = blockIdx.x >> 3;
  const int nchunk8 = (int)(gridDim.x >> 3);
  const h16* Wt = (const h16*)(P.ws + OFF_WTIN) + (size_t)l * NPAD * DM;
  const h16* A = (const h16*)(P.ws + OFF_U);
  const int NTn = NPAD / 128;
  const int ntiles = NTn * (MTOK / 256);
  h16* sW = (h16*)lds;
  h16* sU = sW + 128 * 64;
  int tid = threadIdx.x;
  asm volatile("" : "+v"(tid));
  int lane = tid & 63, wave = tid >> 6;
  int wn = wave & 1, wm = wave >> 1;
  int lr = lane & 15, quad = lane >> 4;
  int ld_row = tid >> 3, ld_k = (tid & 7) * 8;
  const int pc = ((tid & 7) ^ ((ld_row >> 1) & 7)) * 8;
  const int sw0 = (quad ^ ((lr >> 1) & 7)) * 8;
  const int RN = 7, nrn = NTn / RN;
  for (int it = 0;; ++it) {
    int tile = (it * 8 + xcd) * nchunk8 + lj;
    if (tile >= ntiles) break;
    int rect = tile / (8 * RN), within = tile % (8 * RN);
    int mt = (rect / nrn) * 8 + (within & 7), nt = (rect % nrn) * RN + (within >> 3);
    int n0 = nt * 128, m0 = mt * 256;
    const h16* gW = Wt + (size_t)n0 * DM;
    const h16* gU = A + (size_t)m0 * DM;
    const unsigned voff = (unsigned)(ld_row * DM + ld_k) * 2u;
    JStage S;
    f32x4 acc[4][8];
#pragma unroll
    for (int i = 0; i < 4; ++i)
#pragma unroll
      for (int j = 0; j < 8; ++j) acc[i][j] = (f32x4){0.f, 0.f, 0.f, 0.f};
    j_load(S, gW, gU, voff);
    j_store(S, sW, sU, ld_row, pc);
    __syncthreads();
    const h16* cW = sW + (wn * 64 + lr) * 64;
    const h16* cU = sU + (wm * 128 + lr) * 64;
    for (int kt = 0; kt < 32; ++kt) {
      { const int kn = min(kt + 1, 31) * 64; j_load(S, gW + kn, gU + kn, voff); }
      __builtin_amdgcn_s_setprio(1);
      j_compute(acc, cW, cU, sw0);
      __builtin_amdgcn_s_setprio(0);
      __syncthreads();
      j_store(S, sW, sU, ld_row, pc);
      __syncthreads();
    }
    {
      bool lat = (m0 >= MCTX);
      if (lat && n0 < C_VA) {
        const float2* rope = (const float2*)(P.ws + OFF_ROPE);
#pragma unroll
        for (int j = 0; j < 8; ++j) {
          int m = m0 + wm * 128 + j * 16 + lr;
          int t = (m - MCTX) & 1023;
#pragma unroll
          for (int i = 0; i < 2; ++i)
#pragma unroll
            for (int jj = 0; jj < 4; ++jj) {
              float2 cs = rope[t * 64 + wn * 32 + i * 16 + quad * 4 + jj];
              float x1 = acc[i][j][jj], x2 = acc[i + 2][j][jj];
              acc[i][j][jj] = x1 * cs.x - x2 * cs.y;
              acc[i + 2][j][jj] = x1 * cs.y + x2 * cs.x;
            }
        }
      }
      h16* proj = (h16*)(P.ws + OFF_PROJ);
#pragma unroll
      for (int i = 0; i < 4; ++i) {
        int n = n0 + wn * 64 + i * 16 + quad * 4;
        if (n >= DPROJ) continue;
        bool isVa = (n >= C_VA && n < C_GA);
        bool isVd = (n >= C_VD && n < C_GD);
#pragma unroll
        for (int j = 0; j < 8; ++j) {
          int m = m0 + wm * 128 + j * 16 + lr;
          f32x4 v = acc[i][j];
          if (isVa || isVd) {
            int nn = isVa ? n - C_VA : n - C_VD;
            h16* dst;
            int T, t;
            if (!lat) {
              int b = m >> 8; t = m & 255; T = 256;
              dst = isVa ? (h16*)(P.ws + OFF_VTA_CTX) + ((size_t)b * 256 + nn) * 256
                         : (h16*)(P.ws + OFF_VTD_CTX) + ((size_t)b * 512 + nn) * 256;
            } else {
              int b = (m - MCTX) >> 10; t = (m - MCTX) & 1023; T = 1024;
              dst = isVa ? (h16*)(P.ws + OFF_VTA_LAT) + ((size_t)b * 256 + nn) * 1024
                         : (h16*)(P.ws + OFF_VTD_LAT) + ((size_t)b * 512 + nn) * 1024;
            }
#pragma unroll
            for (int jj = 0; jj < 4; ++jj) dst[(size_t)jj * T + t] = (h16)v[jj];
          } else {
            *(h16x4*)(proj + (size_t)m * DPROJ + n) = pack4(v);
          }
          if (!lat) {
            int b = m >> 8, t = m & 255;
            size_t r = ((size_t)(b * 2 + l) * 256 + t);
            float* o = nullptr;
            if (n >= C_KA && n < C_VA) o = P.out + O_NAK + r * 256 + (n - C_KA);
            else if (isVa) o = P.out + O_NAV + r * 256 + (n - C_VA);
            else if (n >= C_KD && n < C_VD) o = P.out + O_NNK + r * 512 + (n - C_KD);
            else if (isVd) o = P.out + O_NNV + r * 512 + (n - C_VD);
            if (o) *(float4*)o = make_float4(v[0], v[1], v[2], v[3]);
          }
        }
      }
    }
  }
}

#define KLS 136
#define VLS 72
__device__ __forceinline__ void attn_unit(const Params& P, int l, int mode, int b, int h, int qt, char* lds) {
  h16* sK0 = (h16*)lds;
  h16* sVT0 = sK0 + 2 * 64 * KLS;
  float* sRpb = (float*)(sVT0 + 2 * 128 * VLS);
  int tid = threadIdx.x;
  asm volatile("" : "+v"(tid));
  int lane = tid & 63, wave = tid >> 6;
  int lr = lane & 15, quad = lane >> 4;
  const bool isA = (mode == 0 || mode == 2);
  const bool lat = (mode >= 2);
  const int T = lat ? 1024 : 256;
  const int rowbase = lat ? MCTX + b * 1024 : b * 256;
  const int qcol = isA ? C_QA : C_QD, kcol = isA ? C_KA : C_KD, gcol = isA ? C_GA : C_GD, ocol = isA ? 0 : 1536;
  const int nkv = isA ? 2 : 4;
  const int kvh = isA ? (h >> 1) : h;
  const h16* proj = (const h16*)(P.ws + OFF_PROJ);
  const h16* Kown = proj + (size_t)rowbase * DPROJ + kcol + kvh * 128;
  const h16* VTown = (const h16*)(P.ws + (isA ? (lat ? OFF_VTA_LAT : OFF_VTA_CTX) : (lat ? OFF_VTD_LAT : OFF_VTD_CTX))) +
                     ((size_t)(b * nkv + kvh) * 128) * T;
  const h16* Kc = (const h16*)(P.ws + (isA ? OFF_KCA : OFF_KCD)) + ((size_t)(b * 2 + l) * 256) * (nkv * 128) + kvh * 128;
  const h16* VTc = (const h16*)(P.ws + (isA ? OFF_VTAC : OFF_VTDC)) + ((size_t)((b * 2 + l) * nkv + kvh) * 128) * 256;
  const int q0 = qt * 64;
  int n0t, start0;
  if (mode < 2) { n0t = 4; start0 = 0; }
  else if (mode == 2) {
    int lo = q0 - 128; if (lo < 0) lo = 0;
    int hi = q0 + 192; if (hi > T) hi = T;
    start0 = lo; n0t = (hi - lo) >> 6;
  } else {
    int rs = qt - 4; if (rs < 0) rs = 0; if (rs > 8) rs = 8;
    start0 = rs * 64; n0t = 8;
  }
  const int ntot = n0t + (lat ? 4 : 0);
  __syncthreads();
  if (mode == 3) {
    const float* rpb = P.in[I_RPB] + ((size_t)l * 4 + h) * 15 * 31;
    for (int i = tid; i < 15 * 31; i += NTHREADS) sRpb[i] = rpb[i];
  }
  const int qi = wave * 16 + lr;
  const h16* qrow = proj + (size_t)(rowbase + q0 + qi) * DPROJ + qcol + h * 128 + quad * 8;
  h16x8 qf[4];
#pragma unroll
  for (int ks = 0; ks < 4; ++ks) qf[ks] = *(const h16x8*)(qrow + ks * 32);
  const float scale = 0.08838834764831845f;
  float m_run = -1e30f, l_run = 0.f;
  f32x4 O[8];
#pragma unroll
  for (int d = 0; d < 8; ++d) O[d] = (f32x4){0.f, 0.f, 0.f, 0.f};
  const int qpos = q0 + qi;
  const int qc = qi;
  int cs = qc - 8; if (cs < 0) cs = 0; if (cs > 48) cs = 48;

  u32x4 rk0, rk1, rk2, rk3, rv0, rv1, rv2, rv3;
  const int kr = tid >> 4, kch = (tid & 15) * 8;
  const int vr = tid >> 3, vch = (tid & 7) * 8;
#define ATT_LOAD(IT)                                                                              \
  {                                                                                               \
    const bool own_ = (IT) < n0t;                                                                 \
    const int ks_ = own_ ? start0 + (IT) * 64 : ((IT) - n0t) * 64;                                \
    const h16* Kp_ = own_ ? Kown + (size_t)ks_ * DPROJ : Kc + (size_t)ks_ * (nkv * 128);          \
    const size_t kst_ = own_ ? DPROJ : nkv * 128;                                                 \
    const h16* Vp_ = own_ ? VTown + ks_ : VTc + ks_;                                              \
    const size_t vst_ = own_ ? T : 256;                                                           \
    rk0 = *(const u32x4*)(Kp_ + (size_t)(kr) * kst_ + kch);                                       \
    rk1 = *(const u32x4*)(Kp_ + (size_t)(kr + 16) * kst_ + kch);                                  \
    rk2 = *(const u32x4*)(Kp_ + (size_t)(kr + 32) * kst_ + kch);                                  \
    rk3 = *(const u32x4*)(Kp_ + (size_t)(kr + 48) * kst_ + kch);                                  \
    rv0 = *(const u32x4*)(Vp_ + (size_t)(vr) * vst_ + vch);                                       \
    rv1 = *(const u32x4*)(Vp_ + (size_t)(vr + 32) * vst_ + vch);                                  \
    rv2 = *(const u32x4*)(Vp_ + (size_t)(vr + 64) * vst_ + vch);                                  \
    rv3 = *(const u32x4*)(Vp_ + (size_t)(vr + 96) * vst_ + vch);                                  \
  }
#define ATT_STORE(BUF)                                                        \
  {                                                                           \
    h16* k_ = sK0 + (BUF) * 64 * KLS + kr * KLS + kch;                        \
    h16* v_ = sVT0 + (BUF) * 128 * VLS + vr * VLS + vch;                      \
    *(u32x4*)(k_) = rk0; *(u32x4*)(k_ + 16 * KLS) = rk1;                      \
    *(u32x4*)(k_ + 32 * KLS) = rk2; *(u32x4*)(k_ + 48 * KLS) = rk3;           \
    *(u32x4*)(v_) = rv0; *(u32x4*)(v_ + 32 * VLS) = rv1;                      \
    *(u32x4*)(v_ + 64 * VLS) = rv2; *(u32x4*)(v_ + 96 * VLS) = rv3;           \
  }
  ATT_LOAD(0);
  ATT_STORE(0);
  if (ntot > 1) ATT_LOAD(1);
  __syncthreads();
  for (int it = 0; it < ntot; ++it) {
    const bool own = it < n0t;
    const int kstart = own ? start0 + it * 64 : (it - n0t) * 64;
    if (it + 1 < ntot) ATT_STORE((it + 1) & 1);
    if (it + 2 < ntot) ATT_LOAD(it + 2);
    const h16* sK = sK0 + (it & 1) * 64 * KLS;
    const h16* sVT = sVT0 + (it & 1) * 128 * VLS;
    f32x4 s[4];
#pragma unroll
    for (int kf = 0; kf < 4; ++kf) {
      s[kf] = (f32x4){0.f, 0.f, 0.f, 0.f};
#pragma unroll
      for (int ks = 0; ks < 4; ++ks) {
        h16x8 a = *(const h16x8*)(sK + (kf * 16 + lr) * KLS + ks * 32 + quad * 8);
        s[kf] = mfma16(a, qf[ks], s[kf]);
      }
    }
    float mx = -1e30f;
#pragma unroll
    for (int kf = 0; kf < 4; ++kf)
#pragma unroll
      for (int jj = 0; jj < 4; ++jj) {
        float v = s[kf][jj] * scale;
        int kk = kf * 16 + quad * 4 + jj;
        if (own && mode == 2) {
          int d = kstart + kk - qpos;
          if (d > 128 || d < -128) v = -1e30f;
        } else if (own && mode == 3) {
          if (kk >= cs && kk < cs + 16) {
            int dy = (kstart >> 6) - qt;
            int dx = kk - qc; if (dx < -15) dx = -15; if (dx > 15) dx = 15;
            v += sRpb[(dy + 7) * 31 + dx + 15];
          } else v = -1e30f;
        }
        s[kf][jj] = v;
        mx = fmaxf(mx, v);
      }
    mx = fmaxf(mx, __shfl_xor(mx, 16));
    mx = fmaxf(mx, __shfl_xor(mx, 32));
    float m_new = fmaxf(m_run, mx);
    float alpha = __expf(m_run - m_new);
    float psum = 0.f;
#pragma unroll
    for (int kf = 0; kf < 4; ++kf)
#pragma unroll
      for (int jj = 0; jj < 4; ++jj) {
        float p = __expf(s[kf][jj] - m_new);
        s[kf][jj] = p;
        psum += p;
      }
    l_run = l_run * alpha + psum;
    m_run = m_new;
#pragma unroll
    for (int d = 0; d < 8; ++d) { O[d][0] *= alpha; O[d][1] *= alpha; O[d][2] *= alpha; O[d][3] *= alpha; }
#pragma unroll
    for (int kk2 = 0; kk2 < 2; ++kk2) {
      h16x8 pb = pack8(s[2 * kk2], s[2 * kk2 + 1]);
#pragma unroll
      for (int d = 0; d < 8; ++d) {
        const h16* vr = sVT + (d * 16 + lr) * VLS + quad * 4;
        h16x8 a = read_split(vr + (2 * kk2) * 16, vr + (2 * kk2 + 1) * 16);
        O[d] = mfma16(a, pb, O[d]);
      }
    }
    __syncthreads();
  }
#undef ATT_LOAD
#undef ATT_STORE
  l_run += __shfl_xor(l_run, 16);
  l_run += __shfl_xor(l_run, 32);
  if (isA) l_run += __expf(P.in[I_SINK][l * 4 + h] - m_run);
  float inv = 1.f / l_run;
  const size_t row = (size_t)(rowbase + q0 + qi);
  const h16* grow = proj + row * DPROJ + gcol + h * 128;
  h16* orow = (h16*)(P.ws + OFF_U) + row * DM + ocol + h * 128;
#pragma unroll
  for (int d = 0; d < 8; ++d) {
    int dd = d * 16 + quad * 4;
    h16x4 g = *(const h16x4*)(grow + dd);
    h16x4 o;
#pragma unroll
    for (int jj = 0; jj < 4; ++jj) o[jj] = (h16)(O[d][jj] * inv * silu_f((float)g[jj]));
    *(h16x4*)(orow + dd) = o;
  }
}

__device__ __forceinline__ void conv_load(const Params& P, int l, int row0, int T, int t0, int ntok, int xcol, int ncols, h16* dst,
                          int dstride, bool transposed) {
  const h16* proj = (const h16*)(P.ws + OFF_PROJ);
  const float* cw = P.in[I_CONVW] + (size_t)l * 5 * 1024;
  const float* cb = P.in[I_CONVB] + (size_t)l * 1024;
  int tid0 = threadIdx.x;
  asm volatile("" : "+v"(tid0));
  int gpt = ncols >> 3;
  int total = ntok * gpt;
#pragma unroll 1
  for (int idx = tid0; idx < total; idx += NTHREADS) {
    int tl = idx / gpt, c = (idx % gpt) * 8;
    int t = t0 + tl;
    float acc[8];
    {
      float4 b0 = *(const float4*)(cb + xcol + c), b1 = *(const float4*)(cb + xcol + c + 4);
      acc[0] = b0.x; acc[1] = b0.y; acc[2] = b0.z; acc[3] = b0.w;
      acc[4] = b1.x; acc[5] = b1.y; acc[6] = b1.z; acc[7] = b1.w;
    }
#pragma unroll
    for (int k = 0; k < 5; ++k) {
      int tt = t + k - 2;
      if (tt >= 0 && tt < T) {
        h16x8 x = *(const h16x8*)(proj + (size_t)(row0 + tt) * DPROJ + C_XBC + xcol + c);
        float4 w0 = *(const float4*)(cw + k * 1024 + xcol + c), w1 = *(const float4*)(cw + k * 1024 + xcol + c + 4);
        acc[0] += w0.x * (float)x[0]; acc[1] += w0.y * (float)x[1]; acc[2] += w0.z * (float)x[2]; acc[3] += w0.w * (float)x[3];
        acc[4] += w1.x * (float)x[4]; acc[5] += w1.y * (float)x[5]; acc[6] += w1.z * (float)x[6]; acc[7] += w1.w * (float)x[7];
      }
    }
    h16x8 o;
#pragma unroll
    for (int e = 0; e < 8; ++e) o[e] = (h16)silu_f(acc[e]);
    if (!transposed) *(h16x8*)(dst + tl * dstride + c) = o;
    else {
#pragma unroll
      for (int e = 0; e < 8; ++e) dst[(c + e) * dstride + tl] = o[e];
    }
  }
}

__device__ __forceinline__ float softplus_f(float x) { return x > 20.f ? x : log1pf(__expf(x)); }

__device__ __forceinline__ void chunk_scan(const Params& P, int l, int row_chunk0, int dir, int h, int lane, float& dt0,
                                           float& dt1, float& L0, float& L1, int& tk0, int& tk1) {
  const h16* proj = (const h16*)(P.ws + OFF_PROJ);
  float bias = P.in[I_DTB][(l * 2 + dir) * 8 + h];
  float A = -__expf(P.in[I_ALOG][(l * 2 + dir) * 8 + h]);
  int e0 = 2 * lane, e1 = 2 * lane + 1;
  tk0 = dir ? 127 - e0 : e0;
  tk1 = dir ? 127 - e1 : e1;
  dt0 = softplus_f((float)proj[(size_t)(row_chunk0 + tk0) * DPROJ + C_DT + dir * 8 + h] + bias);
  dt1 = softplus_f((float)proj[(size_t)(row_chunk0 + tk1) * DPROJ + C_DT + dir * 8 + h] + bias);
  float a0 = dt0 * A, a1 = dt1 * A;
  float s = a0 + a1;
  float inc = s;
#pragma unroll
  for (int o = 1; o < 64; o <<= 1) {
    float v = __shfl_up(inc, o);
    if (lane >= o) inc += v;
  }
  float excl = inc - s;
  L0 = excl + a0;
  L1 = excl + a0 + a1;
}

#define TLS 1032
__device__ __forceinline__ void conv_unit(const Params& P, int l, int tile, char* lds) {
  int tid = threadIdx.x;
  asm volatile("" : "+v"(tid));
  const int rowt = tile * 32;
  const bool lat = rowt >= MCTX;
  const int T = lat ? 1024 : 256;
  const int row0 = lat ? MCTX + (((rowt - MCTX) >> 10) << 10) : (rowt >> 8) << 8;
  const int t0 = rowt - row0;
  h16* tileS = (h16*)lds;
  const h16* proj = (const h16*)(P.ws + OFF_PROJ);
  const int c = (tid & 127) * 8, half = tid >> 7;
  const float* cw = P.in[I_CONVW] + (size_t)l * 5 * 1024 + c;
  const float* cb = P.in[I_CONVB] + (size_t)l * 1024 + c;
  float w[5][8], bias[8];
#pragma unroll
  for (int k = 0; k < 5; ++k) {
    float4 a = *(const float4*)(cw + k * 1024), b4 = *(const float4*)(cw + k * 1024 + 4);
    w[k][0] = a.x; w[k][1] = a.y; w[k][2] = a.z; w[k][3] = a.w; w[k][4] = b4.x; w[k][5] = b4.y; w[k][6] = b4.z; w[k][7] = b4.w;
  }
  {
    float4 a = *(const float4*)cb, b4 = *(const float4*)(cb + 4);
    bias[0] = a.x; bias[1] = a.y; bias[2] = a.z; bias[3] = a.w; bias[4] = b4.x; bias[5] = b4.y; bias[6] = b4.z; bias[7] = b4.w;
  }
  __syncthreads();
#pragma unroll
  for (int part = 0; part < 2; ++part) {
    const int tb = t0 + half * 16 + part * 8;
    h16x8 xr[12];
#pragma unroll
    for (int r = 0; r < 12; ++r) {
      int tt = tb + r - 2;
      h16x8 z = {0, 0, 0, 0, 0, 0, 0, 0};
      xr[r] = (tt >= 0 && tt < T) ? *(const h16x8*)(proj + (size_t)(row0 + tt) * DPROJ + C_XBC + c) : z;
    }
#pragma unroll
    for (int i = 0; i < 8; ++i) {
      float acc[8];
#pragma unroll
      for (int e = 0; e < 8; ++e) acc[e] = bias[e];
#pragma unroll
      for (int k = 0; k < 5; ++k)
#pragma unroll
        for (int e = 0; e < 8; ++e) acc[e] += w[k][e] * (float)xr[i + k][e];
      h16x8 o;
#pragma unroll
      for (int e = 0; e < 8; ++e) o[e] = (h16)silu_f(acc[e]);
      *(h16x8*)(tileS + (half * 16 + part * 8 + i) * TLS + c) = o;
    }
  }
  __syncthreads();
  h16* xbcn = (h16*)(P.ws + OFF_XBCN);
#pragma unroll
  for (int i = 0; i < 8; ++i) {
    int idx = tid + i * 256;
    int r = idx >> 6, ch = (idx & 63) * 8;
    *(uint4*)(xbcn + (size_t)(rowt + r) * 512 + ch) = *(const uint4*)(tileS + r * TLS + 512 + ch);
  }
  h16* xt = (h16*)(P.ws + OFF_XT) + (size_t)row0 * 512 + t0;
  h16* bt = (h16*)(P.ws + OFF_BT) + (size_t)row0 * 256 + t0;
#pragma unroll
  for (int i = 0; i < 3; ++i) {
    int ch = tid + i * 256;
    h16* dst = (ch < 512) ? xt + (size_t)ch * T : bt + (size_t)(ch - 512) * T;
#pragma unroll
    for (int q = 0; q < 4; ++q) {
      h16x8 o;
#pragma unroll
      for (int e = 0; e < 8; ++e) o[e] = tileS[(q * 8 + e) * TLS + ch];
      *(h16x8*)(dst + q * 8) = o;
    }
  }
}

__device__ __forceinline__ void conv_phase(const Params& P, int l, char* lds) {
  const int U_CONV = 384, U_SCAN = 384;
  for (int u = blockIdx.x; u < U_CONV + U_SCAN; u += gridDim.x) {
    if (u < U_CONV) { conv_unit(P, l, u, lds); continue; }
    int tid = threadIdx.x;
    asm volatile("" : "+v"(tid));
    int lane = tid & 63, wave = tid >> 6;
    int wt = (u - U_CONV) * 4 + wave;
    int bc = wt >> 4, combo = wt & 15;
    int h = combo >> 1, dir = combo & 1;
    int rowc = (bc < 64) ? (bc >> 1) * 256 + (bc & 1) * 128 : MCTX + ((bc - 64) >> 3) * 1024 + ((bc - 64) & 7) * 128;
    float d0, d1, L0, L1; int k0, k1;
    chunk_scan(P, l, rowc, dir, h, lane, d0, d1, L0, L1, k0, k1);
    float* DT = (float*)(P.ws + OFF_DT) + (size_t)wt * 128;
    float* LL = (float*)(P.ws + OFF_LL) + (size_t)wt * 128;
    DT[k0] = d0; DT[k1] = d1; LL[k0] = L0; LL[k1] = L1;
    if (lane == 63) ((float*)(P.ws + OFF_CDEC))[wt] = __expf(L1);
  }
}

__device__ __forceinline__ void ssd_intra_unit(const Params& P, int l, bool lat, int b, int c, int h, char* lds) {
  const int T = lat ? 1024 : 256;
  const int row0 = lat ? MCTX + b * 1024 : b * 256;
  const int t0 = c * 128;
  const int bc = lat ? 64 + b * 8 + c : b * 2 + c;
  const int g = h >> 2;
  int tid = threadIdx.x;
  asm volatile("" : "+v"(tid));
  int lane = tid & 63, wave = tid >> 6;
  int lr = lane & 15, quad = lane >> 4;
  h16* sC = (h16*)lds;
  h16* sB = sC + 128 * KLS;
  float* fL = (float*)(lds + 69632);
  float* Lf = fL, *Lb = fL + 128, *dtf = fL + 256, *dtb = fL + 384, *wf = fL + 512, *wb = fL + 640;
  h16* sXT = (h16*)lds;
  h16* sBT = sXT + 64 * KLS;
  __syncthreads();
  const h16* xbcn = (const h16*)(P.ws + OFF_XBCN) + (size_t)(row0 + t0) * 512;
  u32x4 rc[8], rb[8];
#pragma unroll
  for (int i = 0; i < 8; ++i) {
    int idx = tid + i * 256;
    int r = idx >> 4, ch = (idx & 15) * 8;
    rc[i] = *(const u32x4*)(xbcn + (size_t)r * 512 + 256 + g * 128 + ch);
    rb[i] = *(const u32x4*)(xbcn + (size_t)r * 512 + g * 128 + ch);
  }
  if (tid < 128) {
    const float* DT = (const float*)(P.ws + OFF_DT) + (size_t)(bc * 16 + h * 2) * 128;
    const float* LL = (const float*)(P.ws + OFF_LL) + (size_t)(bc * 16 + h * 2) * 128;
    float lf = LL[tid], lb = LL[128 + tid], df = DT[tid], db = DT[128 + tid];
    float lfe = LL[127], lbe = LL[128];
    Lf[tid] = lf; Lb[tid] = lb; dtf[tid] = df; dtb[tid] = db;
    wf[tid] = __expf(lfe - lf) * df;
    wb[tid] = __expf(lbe - lb) * db;
  }
#pragma unroll
  for (int i = 0; i < 8; ++i) {
    int idx = tid + i * 256;
    int r = idx >> 4, ch = (idx & 15) * 8;
    *(u32x4*)(sC + r * KLS + ch) = rc[i];
    *(u32x4*)(sB + r * KLS + ch) = rb[i];
  }
  const h16* xtg = (const h16*)(P.ws + OFF_XT) + (size_t)row0 * 512 + (size_t)(h * 64) * T + t0;
  const h16* btg = (const h16*)(P.ws + OFF_BT) + (size_t)row0 * 256 + (size_t)(g * 128) * T + t0;
  u32x4 rx[4], rt[8];
#pragma unroll
  for (int i = 0; i < 4; ++i) {
    int idx = tid + i * 256;
    int r = idx >> 4, ch = (idx & 15) * 8;
    rx[i] = *(const u32x4*)(xtg + (size_t)r * T + ch);
  }
#pragma unroll
  for (int i = 0; i < 8; ++i) {
    int idx = tid + i * 256;
    int r = idx >> 4, ch = (idx & 15) * 8;
    rt[i] = *(const u32x4*)(btg + (size_t)r * T + ch);
  }
  __syncthreads();
  f32x4 acc[8][2];
#pragma unroll
  for (int jf = 0; jf < 8; ++jf) { acc[jf][0] = (f32x4){0.f, 0.f, 0.f, 0.f}; acc[jf][1] = (f32x4){0.f, 0.f, 0.f, 0.f}; }
#pragma unroll
  for (int ks = 0; ks < 4; ++ks) {
    h16x8 bo[2];
#pragma unroll
    for (int f = 0; f < 2; ++f) bo[f] = *(const h16x8*)(sC + (wave * 32 + f * 16 + lr) * KLS + ks * 32 + quad * 8);
#pragma unroll
    for (int jf = 0; jf < 8; ++jf) {
      h16x8 a = *(const h16x8*)(sB + (jf * 16 + lr) * KLS + ks * 32 + quad * 8);
      acc[jf][0] = mfma16(a, bo[0], acc[jf][0]);
      acc[jf][1] = mfma16(a, bo[1], acc[jf][1]);
    }
  }
  h16x8 mb[4][2];
  {
    const int i0 = wave * 32 + lr, i1 = wave * 32 + 16 + lr;
    const float Lfi0 = Lf[i0], Lbi0 = Lb[i0], Lfi1 = Lf[i1], Lbi1 = Lb[i1];
    const int dji = quad * 4 - i0;
#pragma unroll
    for (int kk = 0; kk < 4; ++kk) {
#pragma unroll
      for (int hf = 0; hf < 2; ++hf) {
        const int jf = 2 * kk + hf;
        const int jb = jf * 16 + quad * 4;
        f32x4 lfj = *(const f32x4*)(Lf + jb), lbj = *(const f32x4*)(Lb + jb);
        f32x4 dfj = *(const f32x4*)(dtf + jb), dbj = *(const f32x4*)(dtb + jb);
#pragma unroll
        for (int jj = 0; jj < 4; ++jj) {
          int t0_ = dji + jf * 16 + jj, t1_ = t0_ - 16;
          float mf0 = (float)((unsigned)(t0_ - 1) >> 31), mb0 = (float)((unsigned)(-t0_ - 1) >> 31);
          float mf1 = (float)((unsigned)(t1_ - 1) >> 31), mb1 = (float)((unsigned)(-t1_ - 1) >> 31);
          float w0 = mf0 * dfj[jj] * __expf(fminf(Lfi0 - lfj[jj], 0.f)) + mb0 * dbj[jj] * __expf(fminf(Lbi0 - lbj[jj], 0.f));
          float w1 = mf1 * dfj[jj] * __expf(fminf(Lfi1 - lfj[jj], 0.f)) + mb1 * dbj[jj] * __expf(fminf(Lbi1 - lbj[jj], 0.f));
          acc[jf][0][jj] *= w0;
          acc[jf][1][jj] *= w1;
        }
      }
      mb[kk][0] = pack8(acc[2 * kk][0], acc[2 * kk + 1][0]);
      mb[kk][1] = pack8(acc[2 * kk][1], acc[2 * kk + 1][1]);
      asm volatile("" : "+v"(mb[kk][0]), "+v"(mb[kk][1]));
      __builtin_amdgcn_sched_barrier(0);
    }
  }
  __syncthreads();
#pragma unroll
  for (int i = 0; i < 4; ++i) {
    int idx = tid + i * 256;
    int r = idx >> 4, ch = (idx & 15) * 8;
    *(u32x4*)(sXT + r * KLS + ch) = rx[i];
  }
#pragma unroll
  for (int i = 0; i < 8; ++i) {
    int idx = tid + i * 256;
    int r = idx >> 4, ch = (idx & 15) * 8;
    *(u32x4*)(sBT + r * KLS + ch) = rt[i];
  }
  __syncthreads();
  {
    f32x4 yacc[2][4];
#pragma unroll
    for (int f = 0; f < 2; ++f)
#pragma unroll
      for (int pf = 0; pf < 4; ++pf) yacc[f][pf] = (f32x4){0.f, 0.f, 0.f, 0.f};
#pragma unroll
    for (int kk = 0; kk < 4; ++kk) {
      h16x8 b0 = mb[kk][0];
      h16x8 b1 = mb[kk][1];
#pragma unroll
      for (int pf = 0; pf < 4; ++pf) {
        const h16* xr = sXT + (pf * 16 + lr) * KLS + quad * 4;
        h16x8 a = read_split(xr + (2 * kk) * 16, xr + (2 * kk + 1) * 16);
        yacc[0][pf] = mfma16(a, b0, yacc[0][pf]);
        yacc[1][pf] = mfma16(a, b1, yacc[1][pf]);
      }
      __builtin_amdgcn_sched_barrier(0);
    }
    float* ybuf = (float*)(P.ws + OFF_YBUF);
    const float Dh = P.in[I_SSMD][l * 8 + h];
#pragma unroll
    for (int f = 0; f < 2; ++f) {
      int i = wave * 32 + f * 16 + lr;
#pragma unroll
      for (int pf = 0; pf < 4; ++pf) {
        f32x4 v = yacc[f][pf];
#pragma unroll
        for (int jj = 0; jj < 4; ++jj) v[jj] += Dh * (float)sXT[(pf * 16 + quad * 4 + jj) * KLS + i];
        *(float4*)(ybuf + (size_t)(row0 + t0 + i) * 512 + h * 64 + pf * 16 + quad * 4) = make_float4(v[0], v[1], v[2], v[3]);
      }
    }
  }
#pragma unroll 1
  for (int dir = 0; dir < 2; ++dir) {
    const float* wx = dir ? wb : wf;
    int lr2 = lr;
    asm volatile("" : "+v"(lr2));
    f32x4 sacc[8];
#pragma unroll
    for (int nf = 0; nf < 8; ++nf) sacc[nf] = (f32x4){0.f, 0.f, 0.f, 0.f};
#pragma unroll
    for (int ks = 0; ks < 4; ++ks) {
      int j0 = ks * 32 + quad * 8;
      h16x8 x = *(const h16x8*)(sXT + (wave * 16 + lr2) * KLS + j0);
      f32x4 wa = *(const f32x4*)(wx + j0), wc = *(const f32x4*)(wx + j0 + 4);
      h16x8 xw;
#pragma unroll
      for (int e = 0; e < 4; ++e) {
        xw[e] = (h16)((float)x[e] * wa[e]);
        xw[e + 4] = (h16)((float)x[e + 4] * wc[e]);
      }
#pragma unroll
      for (int nf = 0; nf < 8; ++nf) {
        h16x8 a = *(const h16x8*)(sBT + (nf * 16 + lr2) * KLS + j0);
        sacc[nf] = mfma16(a, xw, sacc[nf]);
      }
    }
    h16* st = (h16*)(P.ws + OFF_STATES) + ((size_t)(bc * 8 + h) * 2 + dir) * 8192;
    int p = wave * 16 + lr;
#pragma unroll
    for (int nf = 0; nf < 8; ++nf) {
      int n = nf * 16 + quad * 4;
      *(h16x4*)(st + p * 128 + n) = pack4(sacc[nf]);
    }
  }
}

__device__ __forceinline__ void pool_unit(const Params& P, int l, int tile, int g, char* lds) {
  int rowt = tile * 64;
  bool lat = rowt >= MCTX;
  int T = lat ? 1024 : 256;
  int row0 = lat ? MCTX + (((rowt - MCTX) >> 10) << 10) : (rowt >> 8) << 8;
  int t0 = rowt - row0;
  int tid = threadIdx.x;
  asm volatile("" : "+v"(tid));
  int lane = tid & 63, wave = tid >> 6;
  int lr = lane & 15, quad = lane >> 4;
  h16* sP = (h16*)lds;
  h16* sA = sP + 80 * KLS;
  const h16* proj = (const h16*)(P.ws + OFF_PROJ);
  __syncthreads();
  for (int idx = tid; idx < 80 * 16; idx += NTHREADS) {
    int r = idx >> 4, c = (idx & 15) * 8;
    int tt = t0 - 8 + r;
    if (tt >= 0 && tt < T)
      *(uint4*)(sP + r * KLS + c) = *(const uint4*)(proj + (size_t)(row0 + tt) * DPROJ + C_PC + g * 128 + c);
  }
  __syncthreads();
  const int w = 2 << g;
  for (int idx = tid; idx < 64 * 16; idx += NTHREADS) {
    int tl = idx >> 4, c = (idx & 15) * 8;
    int t = t0 + tl;
    int lo = t - (w >> 1); if (lo < 0) lo = 0;
    int hi = t - (w >> 1) + w; if (hi > T) hi = T;
    float s[8];
#pragma unroll
    for (int e = 0; e < 8; ++e) s[e] = 0.f;
    for (int tt = lo; tt < hi; ++tt) {
      h16x8 x = *(const h16x8*)(sP + (tt - t0 + 8) * KLS + c);
#pragma unroll
      for (int e = 0; e < 8; ++e) s[e] += (float)x[e];
    }
    float invn = 1.f / (float)(hi - lo);
    h16x8 self = *(const h16x8*)(sP + (tl + 8) * KLS + c);
    h16x8 o;
#pragma unroll
    for (int e = 0; e < 8; ++e) o[e] = (h16)(s[e] * invn - (float)self[e]);
    *(h16x8*)(sA + tl * KLS + c) = o;
  }
  __syncthreads();
  const h16* WT = (const h16*)(P.ws + OFF_POOLWT) + (size_t)(l * 4 + g) * 128 * 128;
  f32x4 acc[8];
#pragma unroll
  for (int d = 0; d < 8; ++d) acc[d] = (f32x4){0.f, 0.f, 0.f, 0.f};
#pragma unroll
  for (int ks = 0; ks < 4; ++ks) {
    h16x8 bo = *(const h16x8*)(sA + (wave * 16 + lr) * KLS + ks * 32 + quad * 8);
#pragma unroll
    for (int d = 0; d < 8; ++d) {
      h16x8 a = *(const h16x8*)(WT + (d * 16 + lr) * 128 + ks * 32 + quad * 8);
      acc[d] = mfma16(a, bo, acc[d]);
    }
  }
  size_t row = (size_t)rowt + wave * 16 + lr;
  const float* pb = P.in[I_POOLB] + (l * 4 + g) * 128;
  const float* ps = P.in[I_POOLS] + l * 512 + g * 128;
  const h16* grow = proj + row * DPROJ + C_GC + g * 128;
  h16* orow = (h16*)(P.ws + OFF_U) + row * DM + 1024 + g * 128;
#pragma unroll
  for (int d = 0; d < 8; ++d) {
    int dd = d * 16 + quad * 4;
    float4 b4 = *(const float4*)(pb + dd), s4 = *(const float4*)(ps + dd);
    h16x4 gt = *(const h16x4*)(grow + dd);
    h16x4 o;
    o[0] = (h16)((acc[d][0] + b4.x) * s4.x * silu_f((float)gt[0]));
    o[1] = (h16)((acc[d][1] + b4.y) * s4.y * silu_f((float)gt[1]));
    o[2] = (h16)((acc[d][2] + b4.z) * s4.z * silu_f((float)gt[2]));
    o[3] = (h16)((acc[d][3] + b4.w) * s4.w * silu_f((float)gt[3]));
    *(h16x4*)(orow + dd) = o;
  }
}

__device__ __forceinline__ void mix1_phase(const Params& P, int l, char* lds) {
  const int U_LD = 256, U_LA = 256, U_SSL = 256, U_SSC = 512, U_CA = 512, U_CD = 512, U_POOL = 768;
  const int total = U_LD + U_LA + U_SSL + U_SSC + U_CA + U_CD + U_POOL;
  for (int u = blockIdx.x; u < total; u += gridDim.x) {
    int v = u;
    if (v < U_LD) { attn_unit(P, l, 3, v >> 6, (v >> 4) & 3, v & 15, lds); continue; }
    v -= U_LD;
    if (v < U_LA) { attn_unit(P, l, 2, v >> 6, (v >> 4) & 3, v & 15, lds); continue; }
    v -= U_LA;
    if (v < U_SSL) { ssd_intra_unit(P, l, true, v >> 6, (v >> 3) & 7, v & 7, lds); continue; }
    v -= U_SSL;
    if (v < U_SSC) { ssd_intra_unit(P, l, false, v >> 4, (v >> 3) & 1, v & 7, lds); continue; }
    v -= U_SSC;
    if (v < U_CA) { attn_unit(P, l, 0, v >> 4, (v >> 2) & 3, v & 3, lds); continue; }
    v -= U_CA;
    if (v < U_CD) { attn_unit(P, l, 1, v >> 4, (v >> 2) & 3, v & 3, lds); continue; }
    v -= U_CD;
    pool_unit(P, l, v >> 2, v & 3, lds);
  }
}

__device__ __forceinline__ h16x8 hstart_frag(const Params& P, int l, bool lat, int b, int c, int h, int dir, int p, int n) {
  if (!lat) {
    bool zero = (dir == 0) ? (c == 0) : (c == 1);
    h16x8 z = {0, 0, 0, 0, 0, 0, 0, 0};
    if (zero) return z;
    int bc = b * 2 + (dir == 0 ? 0 : 1);
    return *(const h16x8*)((const h16*)(P.ws + OFF_STATES) + ((size_t)(bc * 8 + h) * 2 + dir) * 8192 + p * 128 + n);
  }
  return *(const h16x8*)((const h16*)(P.ws + OFF_HS) + ((size_t)(((b * 8 + c) * 8 + h) * 2 + dir)) * 8192 + p * 128 + n);
}

#define CLS 264
#define XLS 520
__device__ __forceinline__ void ssd_inter_unit(const Params& P, int l, bool lat, int b, int c, int sub, char* lds) {
  const int T = lat ? 1024 : 256;
  const int row0 = lat ? MCTX + b * 1024 : b * 256;
  const int tc0 = c * 128;
  const int t0 = tc0 + sub * 32;
  int tid = threadIdx.x;
  asm volatile("" : "+v"(tid));
  int lane = tid & 63, wave = tid >> 6;
  int lr = lane & 15, quad = lane >> 4;
  h16* sC = (h16*)lds;
  h16* sX = sC + 32 * CLS;
  float* eL = (float*)(lds + 50176);
  float* sred = eL + 16 * 32;
  const h16* proj = (const h16*)(P.ws + OFF_PROJ);
  __syncthreads();
  const int bc = lat ? 64 + b * 8 + c : b * 2 + c;
  {
    const float* LL = (const float*)(P.ws + OFF_LL) + (size_t)bc * 16 * 128 + sub * 32;
#pragma unroll
    for (int i = 0; i < 2; ++i) {
      int idx = tid + i * 256;
      int combo = idx >> 5, r = idx & 31;
      eL[combo * 32 + r] = __expf(LL[combo * 128 + r]);
    }
    const h16* xbcn = (const h16*)(P.ws + OFF_XBCN) + (size_t)(row0 + t0) * 512 + 256;
#pragma unroll
    for (int i = 0; i < 4; ++i) {
      int idx = tid + i * 256;
      int r = idx >> 5, ch = (idx & 31) * 8;
      *(uint4*)(sC + r * CLS + ch) = *(const uint4*)(xbcn + (size_t)r * 512 + ch);
    }
  }
  __syncthreads();
  float ssq[2] = {0.f, 0.f};
  const float* ybuf = (const float*)(P.ws + OFF_YBUF);
#pragma unroll 1
  for (int hh = 0; hh < 2; ++hh) {
    const int h = wave * 2 + hh;
    const int g = h >> 2;
    float vals[4][2][4];
#pragma unroll
    for (int pf = 0; pf < 4; ++pf)
#pragma unroll
      for (int f = 0; f < 2; ++f)
#pragma unroll
        for (int jj = 0; jj < 4; ++jj) vals[pf][f][jj] = 0.f;
#pragma unroll 1
    for (int dir = 0; dir < 2; ++dir) {
      f32x4 acc[4][2];
#pragma unroll
      for (int pf = 0; pf < 4; ++pf) { acc[pf][0] = (f32x4){0.f, 0.f, 0.f, 0.f}; acc[pf][1] = (f32x4){0.f, 0.f, 0.f, 0.f}; }
#pragma unroll
      for (int ks = 0; ks < 4; ++ks) {
        h16x8 b0 = *(const h16x8*)(sC + (lr)*CLS + g * 128 + ks * 32 + quad * 8);
        h16x8 b1 = *(const h16x8*)(sC + (16 + lr) * CLS + g * 128 + ks * 32 + quad * 8);
#pragma unroll
        for (int pf = 0; pf < 4; ++pf) {
          h16x8 a = hstart_frag(P, l, lat, b, c, h, dir, pf * 16 + lr, ks * 32 + quad * 8);
          acc[pf][0] = mfma16(a, b0, acc[pf][0]);
          acc[pf][1] = mfma16(a, b1, acc[pf][1]);
        }
      }
      float e0 = eL[(h * 2 + dir) * 32 + lr], e1 = eL[(h * 2 + dir) * 32 + 16 + lr];
#pragma unroll
      for (int pf = 0; pf < 4; ++pf)
#pragma unroll
        for (int jj = 0; jj < 4; ++jj) {
          vals[pf][0][jj] += e0 * acc[pf][0][jj];
          vals[pf][1][jj] += e1 * acc[pf][1][jj];
        }
    }
#pragma unroll
    for (int f = 0; f < 2; ++f) {
      int il = f * 16 + lr;
      size_t row = (size_t)(row0 + t0 + il);
#pragma unroll
      for (int pf = 0; pf < 4; ++pf) {
        int ch = h * 64 + pf * 16 + quad * 4;
        float4 yi = *(const float4*)(ybuf + row * 512 + ch);
        h16x4 zv = *(const h16x4*)(proj + row * DPROJ + C_Z + ch);
        float y0 = vals[pf][f][0] + yi.x;
        float y1 = vals[pf][f][1] + yi.y;
        float y2 = vals[pf][f][2] + yi.z;
        float y3 = vals[pf][f][3] + yi.w;
        y0 *= silu_f((float)zv[0]); y1 *= silu_f((float)zv[1]); y2 *= silu_f((float)zv[2]); y3 *= silu_f((float)zv[3]);
        ssq[f] += y0 * y0 + y1 * y1 + y2 * y2 + y3 * y3;
        h16x4 o;
        o[0] = (h16)y0; o[1] = (h16)y1; o[2] = (h16)y2; o[3] = (h16)y3;
        *(h16x4*)(sX + il * XLS + ch) = o;
      }
    }
  }
#pragma unroll
  for (int f = 0; f < 2; ++f) {
    ssq[f] += __shfl_xor(ssq[f], 16);
    ssq[f] += __shfl_xor(ssq[f], 32);
    if (quad == 0) sred[wave * 32 + f * 16 + lr] = ssq[f];
  }
  __syncthreads();
  const float* nw = P.in[I_NORMW] + l * 512;
  h16* mixed = (h16*)(P.ws + OFF_U);
#pragma unroll
  for (int f = 0; f < 2; ++f) {
    int il = f * 16 + lr;
    float tot = sred[il] + sred[32 + il] + sred[64 + il] + sred[96 + il];
    float rstd = rsqrtf(tot * (1.f / 512.f) + 1e-6f);
    size_t row = (size_t)(row0 + t0 + il);
#pragma unroll 1
    for (int hh = 0; hh < 2; ++hh) {
      int h = wave * 2 + hh;
#pragma unroll
      for (int pf = 0; pf < 4; ++pf) {
        int ch = h * 64 + pf * 16 + quad * 4;
        float4 w4 = *(const float4*)(nw + ch);
        h16x4 yv = *(const h16x4*)(sX + il * XLS + ch);
        h16x4 o;
        o[0] = (h16)((float)yv[0] * rstd * w4.x);
        o[1] = (h16)((float)yv[1] * rstd * w4.y);
        o[2] = (h16)((float)yv[2] * rstd * w4.z);
        o[3] = (h16)((float)yv[3] * rstd * w4.w);
        *(h16x4*)(mixed + row * DM + 512 + ch) = o;
      }
    }
  }
}

__device__ __forceinline__ void scan_phase(const Params& P, int l) {
  const int U_LAT = 512, U_FIN = 512;
  const float* h0f_ = P.in[I_SF];
  const float* h0b_ = P.in[I_SB];
  asm volatile("" : "+v"(h0f_), "+v"(h0b_));
  int tid = threadIdx.x;
  asm volatile("" : "+v"(tid));
  const h16* st = (const h16*)(P.ws + OFF_STATES);
  const float* cd = (const float*)(P.ws + OFF_CDEC);
  for (int u = blockIdx.x; u < U_LAT + U_FIN; u += gridDim.x) {
    if (u < U_LAT) {
      int sl = u & 7, dir = (u >> 3) & 1, h = (u >> 4) & 7, b = u >> 7;
      int idx = sl * 1024 + tid * 4;
      float4 hv = *(const float4*)((dir == 0 ? h0f_ : h0b_) + ((size_t)((b * 2 + l) * 8 + h)) * 8192 + idx);
      h16x4 sv[8];
      float dc[8];
#pragma unroll
      for (int s_ = 0; s_ < 8; ++s_) {
        int cc = (dir == 0) ? s_ : 7 - s_;
        int bc = 64 + b * 8 + cc;
        sv[s_] = *(const h16x4*)(st + ((size_t)(bc * 8 + h) * 2 + dir) * 8192 + idx);
        dc[s_] = cd[(bc * 8 + h) * 2 + dir];
      }
      h16* hs = (h16*)(P.ws + OFF_HS);
#pragma unroll
      for (int s_ = 0; s_ < 8; ++s_) {
        int cc = (dir == 0) ? s_ : 7 - s_;
        h16x4 o;
        o[0] = (h16)hv.x; o[1] = (h16)hv.y; o[2] = (h16)hv.z; o[3] = (h16)hv.w;
        *(h16x4*)(hs + ((size_t)(((b * 8 + cc) * 8 + h) * 2 + dir)) * 8192 + idx) = o;
        hv.x = dc[s_] * hv.x + (float)sv[s_][0]; hv.y = dc[s_] * hv.y + (float)sv[s_][1];
        hv.z = dc[s_] * hv.z + (float)sv[s_][2]; hv.w = dc[s_] * hv.w + (float)sv[s_][3];
      }
    } else {
      int v = u - U_LAT;
      int dir = v & 1, h = (v >> 1) & 7, b = v >> 4;
      int cfirst = dir == 0 ? 0 : 1, clast = dir == 0 ? 1 : 0;
      int bcf = b * 2 + cfirst, bcl = b * 2 + clast;
      float dcy = cd[(bcl * 8 + h) * 2 + dir];
      const h16* s0 = st + ((size_t)(bcf * 8 + h) * 2 + dir) * 8192;
      const h16* s1 = st + ((size_t)(bcl * 8 + h) * 2 + dir) * 8192;
      float* o = P.out + (dir == 0 ? O_SF : O_SB) + ((size_t)((b * 2 + l) * 8 + h)) * 8192;
#pragma unroll
      for (int i = 0; i < 8; ++i) {
        int idx = (i * 256 + tid) * 4;
        h16x4 a = *(const h16x4*)(s0 + idx), c4 = *(const h16x4*)(s1 + idx);
        *(float4*)(o + idx) = make_float4(dcy * (float)a[0] + (float)c4[0], dcy * (float)a[1] + (float)c4[1],
                                          dcy * (float)a[2] + (float)c4[2], dcy * (float)a[3] + (float)c4[3]);
      }
    }
  }
}

__device__ __forceinline__ void mix2_phase(const Params& P, int l, char* lds) {
  const int U_LAT = 128, U_CTX = 256;
  for (int u = blockIdx.x; u < U_LAT + U_CTX; u += gridDim.x) {
    int v = u;
    if (v < U_LAT) { ssd_inter_unit(P, l, true, v >> 5, (v >> 2) & 7, v & 3, lds); continue; }
    v -= U_LAT;
    ssd_inter_unit(P, l, false, v >> 3, (v >> 2) & 1, v & 3, lds);
  }
}

#define XB_TMO      128
#define XB_XCNT(j)  (256  + 64 * (j))
#define XB_XSUB(j)  (1280 + 64 * (j))
#define XB_XGEN(j)  (2304 + 64 * (j))
#define XB_TOP      3328
#define XB_TOPGEN   3392
#define XCD_BAR_WORDS 3456
#define XB_SPIN_CAP (1u << 18)
#define LAS __attribute__((address_space(3)))
__device__ __forceinline__ unsigned xb_ld(unsigned* p)              { return __hip_atomic_load(p, __ATOMIC_RELAXED, __HIP_MEMORY_SCOPE_AGENT); }
__device__ __forceinline__ unsigned xb_add(unsigned* p, unsigned v) { return __hip_atomic_fetch_add(p, v, __ATOMIC_RELAXED, __HIP_MEMORY_SCOPE_AGENT); }
__device__ __forceinline__ unsigned xb_xcc_id() { return (unsigned)__builtin_amdgcn_s_getreg((3 << 11) | 20) & 0xFu; }
#define XB_SPIN(cond, bar) do { unsigned _sp = 0; while (cond) { __builtin_amdgcn_s_sleep(1); \
    if ((++_sp & 255u) == 0u) { if (xb_ld(&(bar)[XB_TMO])) break; if (_sp > XB_SPIN_CAP) { atomicAdd(&(bar)[XB_TMO], 1u); break; } } } } while (0)
struct XcdBarrier { unsigned* bar; unsigned x; volatile LAS unsigned* st; };
__device__ __forceinline__ XcdBarrier xcd_barrier_post(unsigned* bar, volatile LAS unsigned* st) {
    XcdBarrier b; b.bar = bar; b.x = xb_xcc_id(); b.st = st;
    if (threadIdx.x == 0) (void)xb_add(&bar[XB_XCNT(b.x)], 1u);
    return b;
}
__device__ __forceinline__ void xcd_barrier_complete(unsigned* bar, unsigned x, unsigned& nloc, unsigned& nx) {
    const unsigned G = gridDim.x * gridDim.y * gridDim.z;
    unsigned sum, cnt, mine, sp = 0u;
    for (;;) {
        sum = 0u; cnt = 0u; mine = 0u;
#pragma unroll
        for (unsigned j = 0; j < 16; ++j) { const unsigned c = xb_ld(&bar[XB_XCNT(j)]); sum += c; cnt += (c > 0u) ? 1u : 0u; mine = (j == x) ? c : mine; }
        if (sum == G) break;
        __builtin_amdgcn_s_sleep(1);
        if ((++sp & 255u) == 0u) { if (xb_ld(&bar[XB_TMO])) break; if (sp > XB_SPIN_CAP) { atomicAdd(&bar[XB_TMO], 1u); break; } }
    }
    nloc = mine > 0u ? mine : 1u; nx = cnt > 0u ? cnt : 1u;
}
__device__ __forceinline__ void xcd_barrier(const XcdBarrier& b) {
    asm volatile("s_waitcnt vmcnt(0)" ::: "memory");
    __syncthreads();
    if (threadIdx.x == 0) {
        unsigned* bar = b.bar;
        asm volatile("" : "+v"(bar));
        __builtin_amdgcn_s_waitcnt(0);
        unsigned nloc = b.st[0], nx = b.st[1];
        if (nloc == 0u) { xcd_barrier_complete(bar, b.x, nloc, nx); b.st[0] = nloc; b.st[1] = nx; }
        const unsigned old = xb_add(&bar[XB_XSUB(b.x)], 1u);
        const unsigned gen = old / nloc;
        if (old + 1u == (gen + 1u) * nloc) {
            __builtin_amdgcn_fence(__ATOMIC_RELEASE, "agent");
            asm volatile("s_waitcnt vmcnt(0)" ::: "memory");
            const unsigned og = xb_add(&bar[XB_TOP], 1u);
            const unsigned tg = og / nx;
            if (og + 1u == (tg + 1u) * nx) xb_add(&bar[XB_TOPGEN], 1u);
            else XB_SPIN(xb_ld(&bar[XB_TOPGEN]) == tg, bar);
            __builtin_amdgcn_fence(__ATOMIC_ACQUIRE, "agent");
            xb_add(&bar[XB_XGEN(b.x)], 1u);
            asm volatile("s_waitcnt vmcnt(0)" ::: "memory");
        } else {
            XB_SPIN(xb_ld(&bar[XB_XGEN(b.x)]) == gen, bar);
            __builtin_amdgcn_fence(__ATOMIC_ACQUIRE, "agent");
            asm volatile("s_waitcnt vmcnt(0)" ::: "memory");
        }
    }
    __syncthreads();
}

__global__ void __launch_bounds__(NTHREADS, 2) mega_kernel(Params P) {
  __shared__ __attribute__((aligned(16))) char lds[LDS_BYTES];
  __shared__ uint4 xb_words;
  cg::grid_group grid = cg::this_grid();
  if (P.phase_lo < 0) grid.sync();
  if (threadIdx.x == 0) xb_words = make_uint4(0u, 0u, 0u, 0u);
  __syncthreads();
  XcdBarrier xb = xcd_barrier_post((unsigned*)(P.ws + OFF_BAR), (volatile LAS unsigned*)&xb_words);
  for (int ph = P.phase_lo; ph < P.phase_hi; ++ph) {
    const int l = (ph == 0) ? 0 : (ph - 1) / 7;
    const int k = (ph == 0) ? -1 : (ph == 15 ? 0 : (ph - 1) % 7);
    switch (k) {
      case -1: prep_phase(P, lds); break;
      case 0: if (ph == 1) prep_rest_phase(P, lds); row_phase(P, l); break;
      case 1: gemm_in_phase(P, l, lds); break;
      case 2: conv_phase(P, l, lds); break;
      case 3: mix1_phase(P, l, lds); break;
      case 4: scan_phase(P, l); break;
      case 5: mix2_phase(P, l, lds); break;
      default: gemm_phase<1>(P, l, lds); break;
    }
    if (ph + 1 < P.phase_hi) xcd_barrier(xb);
  }
}

#ifndef MK_MULTI
#define MK_MULTI 0
#endif

extern "C" void kernel_launch(void* const* d_in, const int* in_sizes, int n_in, void* d_out, int out_size, void* d_ws,
                              size_t ws_size, hipStream_t stream) {
  if (ws_size < WS_NEED) {
    fprintf(stderr, "workspace too small: %zu < %zu\n", ws_size, (size_t)WS_NEED);
    return;
  }
  static int grid_blocks = 0;
  if (!grid_blocks) {
    int dev = 0, cus = 0, per_cu = 0;
    hipGetDevice(&dev);
    hipDeviceGetAttribute(&cus, hipDeviceAttributeMultiprocessorCount, dev);
    hipOccupancyMaxActiveBlocksPerMultiprocessor(&per_cu, mega_kernel, NTHREADS, 0);
    if (per_cu > 2) per_cu = 2;
    if (per_cu < 1) per_cu = 1;
    grid_blocks = cus * per_cu;
  }
  Params p{};
  for (int i = 0; i < 27; ++i) p.in[i] = (const float*)d_in[i];
  p.out = (float*)d_out;
  p.ws = (char*)d_ws;
  hipMemsetAsync((char*)d_ws + OFF_MOD, 0, SZ_MOD + SZ_BAR, stream);
#if MK_MULTI
  for (int ph = 0; ph < 16; ++ph) {
    p.phase_lo = ph; p.phase_hi = ph + 1;
    hipLaunchKernelGGL(mega_kernel, dim3(grid_blocks), dim3(NTHREADS), 0, stream, p);
  }
#else
  p.phase_lo = 0; p.phase_hi = 16;
  void* args[] = {&p};
  hipError_t e = hipLaunchCooperativeKernel((void*)mega_kernel, dim3(grid_blocks), dim3(NTHREADS), args, 0, stream);
  if (e != hipSuccess) fprintf(stderr, "cooperative launch failed: %s (grid %d)\n", hipGetErrorString(e), grid_blocks);
#endif
}
```

```cpp
#include <hip/hip_runtime.h>
#include <hip/hip_fp16.h>
#include <hip/hip_cooperative_groups.h>
#include <cstdio>
namespace cg = cooperative_groups;

typedef _Float16 h16;
typedef __attribute__((ext_vector_type(8))) _Float16 h16x8;
typedef __attribute__((ext_vector_type(4))) _Float16 h16x4;
typedef __attribute__((ext_vector_type(4))) float f32x4;

#define DM 2048
#define MTOK 12288
#define MCTX 8192
#define DPROJ 6160
#define NPAD 6272
#define NTHREADS 256

#define C_QA 0
#define C_KA 512
#define C_VA 768
#define C_GA 1024
#define C_XBC 1536
#define C_Z 2560
#define C_DT 3072
#define C_PC 3088
#define C_GC 3600
#define C_QD 4112
#define C_KD 4624
#define C_VD 5136
#define C_GD 5648

#define O_Y 0
#define O_NAK 25165824
#define O_NAV 29360128
#define O_NNK 33554432
#define O_NNV 41943040
#define O_SF 50331648
#define O_SB 54525952

constexpr size_t SZ_WTIN = 2ull * NPAD * DM * 2;
constexpr size_t SZ_WTOUT = 2ull * DM * DM * 2;
constexpr size_t SZ_POOLWT = 2ull * 4 * 128 * 128 * 2;
constexpr size_t SZ_MOD = 2ull * 5 * 6144 * 4;
constexpr size_t SZ_BAR = 14080;
constexpr size_t SZ_ROPE = 1024ull * 64 * 8;
constexpr size_t SZ_KCA = 4ull * 2 * 256 * 256 * 2;
constexpr size_t SZ_KCD = 4ull * 2 * 256 * 512 * 2;
constexpr size_t SZ_VTAC = SZ_KCA;
constexpr size_t SZ_VTDC = SZ_KCD;
constexpr size_t SZ_U = (size_t)MTOK * DM * 2;
constexpr size_t SZ_PROJ = (size_t)MTOK * DPROJ * 2;
constexpr size_t SZ_VTA_CTX = 32ull * 2 * 128 * 256 * 2;
constexpr size_t SZ_VTA_LAT = 4ull * 2 * 128 * 1024 * 2;
constexpr size_t SZ_VTD_CTX = 32ull * 4 * 128 * 256 * 2;
constexpr size_t SZ_VTD_LAT = 4ull * 4 * 128 * 1024 * 2;
constexpr size_t SZ_YBUF = (size_t)MTOK * 512 * 4;
constexpr size_t SZ_STATES = 96ull * 8 * 2 * 8192 * 2;
constexpr size_t SZ_CDEC = 96ull * 8 * 2 * 4;
constexpr size_t SZ_HS = 4ull * 8 * 8 * 2 * 8192 * 2;

constexpr size_t OFF_WTIN = 0;
constexpr size_t OFF_WTOUT = OFF_WTIN + SZ_WTIN;
constexpr size_t OFF_POOLWT = OFF_WTOUT + SZ_WTOUT;
constexpr size_t OFF_MOD = OFF_POOLWT + SZ_POOLWT;
constexpr size_t OFF_BAR = OFF_MOD + SZ_MOD;
constexpr size_t OFF_ROPE = OFF_BAR + SZ_BAR;
constexpr size_t OFF_KCA = OFF_ROPE + SZ_ROPE;
constexpr size_t OFF_KCD = OFF_KCA + SZ_KCA;
constexpr size_t OFF_VTAC = OFF_KCD + SZ_KCD;
constexpr size_t OFF_VTDC = OFF_VTAC + SZ_VTAC;
constexpr size_t OFF_U = OFF_VTDC + SZ_VTDC;
constexpr size_t OFF_PROJ = OFF_U + SZ_U;
constexpr size_t OFF_VTA_CTX = OFF_PROJ + SZ_PROJ;
constexpr size_t OFF_VTA_LAT = OFF_VTA_CTX + SZ_VTA_CTX;
constexpr size_t OFF_VTD_CTX = OFF_VTA_LAT + SZ_VTA_LAT;
constexpr size_t OFF_VTD_LAT = OFF_VTD_CTX + SZ_VTD_CTX;
constexpr size_t OFF_YBUF = OFF_VTD_LAT + SZ_VTD_LAT;
constexpr size_t OFF_STATES = OFF_YBUF + SZ_YBUF;
constexpr size_t OFF_CDEC = OFF_STATES + SZ_STATES;
constexpr size_t OFF_HS = OFF_CDEC + SZ_CDEC + 256;
constexpr size_t SZ_XBCN = (size_t)MTOK * 512 * 2;
constexpr size_t SZ_XT = (size_t)MTOK * 512 * 2;
constexpr size_t SZ_BT = (size_t)MTOK * 256 * 2;
constexpr size_t SZ_DTL = 96ull * 16 * 128 * 4;
constexpr size_t OFF_XBCN = OFF_HS + SZ_HS;
constexpr size_t OFF_XT = OFF_XBCN + SZ_XBCN;
constexpr size_t OFF_BT = OFF_XT + SZ_XT;
constexpr size_t OFF_DT = OFF_BT + SZ_BT;
constexpr size_t OFF_LL = OFF_DT + SZ_DTL;
constexpr size_t WS_NEED = OFF_LL + SZ_DTL + 256;

struct Params {
  const float* in[27];
  float* out;
  char* ws;
  int phase_lo, phase_hi;
};

enum { I_XP = 0, I_XS, I_CAK, I_CAV, I_CNK, I_CNV, I_SF, I_SB, I_C, I_CCTX, I_WADA, I_BADA, I_WIN, I_WOUT,
       I_LNG, I_LNB, I_SINK, I_CONVW, I_CONVB, I_ALOG, I_DTB, I_SSMD, I_NORMW, I_POOLW, I_POOLB, I_POOLS, I_RPB };

#define LDS_BYTES 73728

__device__ __forceinline__ float silu_f(float x) { return x / (1.f + __expf(-x)); }
__device__ __forceinline__ f32x4 mfma16(h16x8 a, h16x8 b, f32x4 c) {
  return __builtin_amdgcn_mfma_f32_16x16x32_f16(a, b, c, 0, 0, 0);
}
__device__ __forceinline__ h16x8 pack8(f32x4 a, f32x4 b) {
  h16x8 r;
  r[0] = (h16)a[0]; r[1] = (h16)a[1]; r[2] = (h16)a[2]; r[3] = (h16)a[3];
  r[4] = (h16)b[0]; r[5] = (h16)b[1]; r[6] = (h16)b[2]; r[7] = (h16)b[3];
  return r;
}
__device__ __forceinline__ h16x4 pack4(f32x4 a) {
  h16x4 r;
  r[0] = (h16)a[0]; r[1] = (h16)a[1]; r[2] = (h16)a[2]; r[3] = (h16)a[3];
  return r;
}
__device__ __forceinline__ h16x8 read_split(const h16* p0, const h16* p1) {
  h16x4 a = *(const h16x4*)p0;
  h16x4 b = *(const h16x4*)p1;
  return __builtin_shufflevector(a, b, 0, 1, 2, 3, 4, 5, 6, 7);
}
__device__ __forceinline__ float wave_sum(float v) {
#pragma unroll
  for (int o = 32; o > 0; o >>= 1) v += __shfl_xor(v, o);
  return v;
}
__device__ __forceinline__ int row_cond(int row) { return row < MCTX ? 0 : 1 + ((row - MCTX) >> 10); }

__device__ __forceinline__ void transpose_tile(const float* __restrict__ src, int sstride, int cvalid, h16* __restrict__ dst,
                               int dstride, int r0, int c0, char* lds) {
  float* tile = (float*)lds;
  int tid = threadIdx.x;
  asm volatile("" : "+v"(tid));
  int c = tid & 63, rr = tid >> 6;
#pragma unroll
  for (int i = 0; i < 16; ++i) {
    int r = i * 4 + rr;
    float v = 0.f;
    if (c0 + c < cvalid) v = src[(size_t)(r0 + r) * sstride + c0 + c];
    tile[r * 65 + c] = v;
  }
  __syncthreads();
  int cc = tid >> 2, rq = (tid & 3) * 16;
  h16x8 o0, o1;
#pragma unroll
  for (int k = 0; k < 8; ++k) {
    o0[k] = (h16)tile[(rq + k) * 65 + cc];
    o1[k] = (h16)tile[(rq + 8 + k) * 65 + cc];
  }
  h16* d = dst + (size_t)(c0 + cc) * dstride + r0 + rq;
  *(h16x8*)d = o0;
  *(h16x8*)(d + 8) = o1;
  __syncthreads();
}

__device__ __forceinline__ void transpose_wide(const float* __restrict__ src, int sstride, int cvalid, h16* __restrict__ dst,
                                               int dstride, int nrows_dst, int r0, int c0, char* lds) {
  float* tile = (float*)lds;
  int tid = threadIdx.x;
  asm volatile("" : "+v"(tid));
  const int lane = tid & 63, rr = tid >> 6;
  const int c4 = lane * 4;
  float4 v[16];
#pragma unroll
  for (int i = 0; i < 16; ++i) {
    int r = rr + 4 * i;
    v[i] = make_float4(0.f, 0.f, 0.f, 0.f);
    if (c0 + c4 < cvalid) v[i] = *(const float4*)(src + (size_t)(r0 + r) * sstride + c0 + c4);
  }
#pragma unroll
  for (int i = 0; i < 16; ++i) *(float4*)(tile + (rr + 4 * i) * 260 + c4) = v[i];
  __syncthreads();
  if (c0 + tid < nrows_dst) {
    h16* d = dst + (size_t)(c0 + tid) * dstride + r0;
#pragma unroll
    for (int q = 0; q < 8; ++q) {
      h16x8 o;
#pragma unroll
      for (int e = 0; e < 8; ++e) o[e] = (h16)tile[(q * 8 + e) * 260 + tid];
      *(h16x8*)(d + q * 8) = o;
    }
  }
  __syncthreads();
}

__device__ __forceinline__ void ada_unit(const Params& P, int u, char* lds) {
  int kc = u & 15;
  int cgp = (u >> 4) % 24;
  int l = u / 384;
  int tid = threadIdx.x;
  asm volatile("" : "+v"(tid));
  int lane = tid & 63, wave = tid >> 6;
  const float* W = P.in[I_WADA] + (size_t)l * DM * 6144;
  int col = cgp * 256 + lane * 4;
  int k0 = kc * 128 + wave * 32;
  float acc[5][4];
#pragma unroll
  for (int c = 0; c < 5; ++c)
#pragma unroll
    for (int e = 0; e < 4; ++e) acc[c][e] = 0.f;
  const float* cctx = P.in[I_CCTX];
  const float* cl = P.in[I_C];
#pragma unroll 8
  for (int k = k0; k < k0 + 32; ++k) {
    float4 w = *(const float4*)(W + (size_t)k * 6144 + col);
    float s[5];
    s[0] = silu_f(cctx[k]);
#pragma unroll
    for (int c = 0; c < 4; ++c) s[c + 1] = silu_f(cl[c * DM + k]);
#pragma unroll
    for (int c = 0; c < 5; ++c) {
      acc[c][0] += s[c] * w.x; acc[c][1] += s[c] * w.y; acc[c][2] += s[c] * w.z; acc[c][3] += s[c] * w.w;
    }
  }
  float* red = (float*)lds;
#pragma unroll
  for (int c = 0; c < 5; ++c)
#pragma unroll
    for (int e = 0; e < 4; ++e) red[(wave * 5 + c) * 256 + lane * 4 + e] = acc[c][e];
  __syncthreads();
  float* mod = (float*)(P.ws + OFF_MOD) + (size_t)l * 5 * 6144;
  int ocol = cgp * 256 + tid;
  float bias = (kc == 0) ? P.in[I_BADA][l * 6144 + ocol] : 0.f;
#pragma unroll
  for (int c = 0; c < 5; ++c) {
    float s = red[(0 * 5 + c) * 256 + tid] + red[(1 * 5 + c) * 256 + tid] + red[(2 * 5 + c) * 256 + tid] +
              red[(3 * 5 + c) * 256 + tid];
    atomicAdd(mod + c * 6144 + ocol, s + bias);
  }
  __syncthreads();
}

__device__ __forceinline__ void prep_unit(const Params& P, int v, char* lds) {
  const int U_ADA = 768, U_WIN = 2 * 32 * 25, U_WOUT = 2 * 32 * 8, U_POOL = 32, U_VTA = 128, U_VTD = 256,
            U_KCA = 128, U_KCD = 256;
  int tid = threadIdx.x;
  asm volatile("" : "+v"(tid));
  {
    if (v < U_ADA) { ada_unit(P, v, lds); return; }
    v -= U_ADA;
    if (v < U_WIN) {
      int l = v / (32 * 25), r = v % (32 * 25);
      int kt = r / 25, ng = r % 25;
      transpose_wide(P.in[I_WIN] + (size_t)l * DM * DPROJ, DPROJ, DPROJ, (h16*)(P.ws + OFF_WTIN) + (size_t)l * NPAD * DM, DM,
                     NPAD, kt * 64, ng * 256, lds);
      return;
    }
    v -= U_WIN;
    if (v < U_WOUT) {
      int l = v / 256, r = v % 256;
      int kt = r / 8, ng = r % 8;
      transpose_wide(P.in[I_WOUT] + (size_t)l * DM * DM, DM, DM, (h16*)(P.ws + OFF_WTOUT) + (size_t)l * DM * DM, DM, DM,
                     kt * 64, ng * 256, lds);
      return;
    }
    v -= U_WOUT;
    if (v < U_POOL) {
      int lg = v >> 2, r = v & 3;
      transpose_tile(P.in[I_POOLW] + (size_t)lg * 128 * 128, 128, 128, (h16*)(P.ws + OFF_POOLWT) + (size_t)lg * 128 * 128,
                     128, (r >> 1) * 64, (r & 1) * 64, lds);
      return;
    }
    v -= U_POOL;
    if (v < U_VTA) {
      int bl = v >> 4, r = v & 15;
      transpose_tile(P.in[I_CAV] + (size_t)bl * 256 * 256, 256, 256, (h16*)(P.ws + OFF_VTAC) + (size_t)bl * 256 * 256, 256,
                     (r >> 2) * 64, (r & 3) * 64, lds);
      return;
    }
    v -= U_VTA;
    if (v < U_VTD) {
      int bl = v >> 5, r = v & 31;
      transpose_tile(P.in[I_CNV] + (size_t)bl * 256 * 512, 512, 512, (h16*)(P.ws + OFF_VTDC) + (size_t)bl * 512 * 256, 256,
                     (r >> 3) * 64, (r & 7) * 64, lds);
      return;
    }
    v -= U_VTD;
    if (v < U_KCA + U_KCD) {
      const float* src;
      h16* dst;
      if (v < U_KCA) { src = P.in[I_CAK]; dst = (h16*)(P.ws + OFF_KCA); }
      else { v -= U_KCA; src = P.in[I_CNK]; dst = (h16*)(P.ws + OFF_KCD); }
      size_t base = (size_t)v * 4096;
#pragma unroll
      for (int i = 0; i < 4; ++i) {
        size_t idx = base + (size_t)(i * 256 + tid) * 4;
        float4 x = *(const float4*)(src + idx);
        h16x4 o;
        o[0] = (h16)x.x; o[1] = (h16)x.y; o[2] = (h16)x.z; o[3] = (h16)x.w;
        *(h16x4*)(dst + idx) = o;
      }
      return;
    }
    v -= U_KCA + U_KCD;
    {
      float2* rope = (float2*)(P.ws + OFF_ROPE);
#pragma unroll
      for (int e = 0; e < 4; ++e) {
        int idx = v * 1024 + e * 256 + tid;
        int t = idx >> 6, j = idx & 63;
        int half = j >> 5, f = j & 31;
        float inv = powf(10000.f, -(float)f / 32.f);
        float pos = half ? (float)(t & 63) : (float)(t >> 6);
        float ang = pos * inv;
        rope[idx] = make_float2(cosf(ang), sinf(ang));
      }
    }
  }
}
__device__ __forceinline__ void prep_phase(const Params& P, char* lds) {
  for (int i = blockIdx.x; i < 384; i += gridDim.x) prep_unit(P, i, lds);
}
#define PREP_REST (384 + 1600 + 512 + 32 + 128 + 256 + 128 + 256 + 64)
__device__ __forceinline__ void prep_rest_phase(const Params& P, char* lds) {
  for (int i = blockIdx.x; i < PREP_REST; i += gridDim.x) prep_unit(P, 384 + i, lds);
}

__device__ __forceinline__ void row_phase(const Params& P, int l) {
  constexpr int RPW = 3;
  int tid = threadIdx.x;
  asm volatile("" : "+v"(tid));
  int lane = tid & 63, wave = tid >> 6;
  float* y = P.out + O_Y;
  h16* U = (h16*)(P.ws + OFF_U);
  const int nwaves = gridDim.x * 4;
  for (int grp = blockIdx.x * 4 + wave; grp * RPW < MTOK; grp += nwaves) {
    float4 x[RPW][8];
#pragma unroll
    for (int r = 0; r < RPW; ++r) {
      int row = grp * RPW + r;
      const float* src;
      if (l == 0) src = (row < MCTX) ? P.in[I_XP] + (size_t)row * DM : P.in[I_XS] + (size_t)(row - MCTX) * DM;
      else src = y + (size_t)row * DM;
#pragma unroll
      for (int i = 0; i < 8; ++i) x[r][i] = *(const float4*)(src + (i * 64 + lane) * 4);
    }
    if (l > 0) {
      const float* g = P.in[I_LNG] + (l - 1) * DM;
      const float* bb = P.in[I_LNB] + (l - 1) * DM;
#pragma unroll
      for (int r = 0; r < RPW; ++r) {
        int row = grp * RPW + r;
        float s = 0.f;
#pragma unroll
        for (int i = 0; i < 8; ++i) s += x[r][i].x + x[r][i].y + x[r][i].z + x[r][i].w;
        float mu = wave_sum(s) * (1.f / DM);
        float q = 0.f;
#pragma unroll
        for (int i = 0; i < 8; ++i) {
          float a = x[r][i].x - mu, b = x[r][i].y - mu, c = x[r][i].z - mu, d = x[r][i].w - mu;
          q += a * a + b * b + c * c + d * d;
        }
        float rstd = rsqrtf(wave_sum(q) * (1.f / DM) + 1e-6f);
#pragma unroll
        for (int i = 0; i < 8; ++i) {
          int c0 = (i * 64 + lane) * 4;
          float4 gg = *(const float4*)(g + c0), b4 = *(const float4*)(bb + c0);
          x[r][i].x = (x[r][i].x - mu) * rstd * gg.x + b4.x;
          x[r][i].y = (x[r][i].y - mu) * rstd * gg.y + b4.y;
          x[r][i].z = (x[r][i].z - mu) * rstd * gg.z + b4.z;
          x[r][i].w = (x[r][i].w - mu) * rstd * gg.w + b4.w;
          *(float4*)(y + (size_t)row * DM + c0) = x[r][i];
        }
      }
    }
    if (l < 2) {
#pragma unroll
      for (int r = 0; r < RPW; ++r) {
        int row = grp * RPW + r;
        float s = 0.f;
#pragma unroll
        for (int i = 0; i < 8; ++i) s += x[r][i].x + x[r][i].y + x[r][i].z + x[r][i].w;
        float mu = wave_sum(s) * (1.f / DM);
        float q = 0.f;
#pragma unroll
        for (int i = 0; i < 8; ++i) {
          float a = x[r][i].x - mu, b = x[r][i].y - mu, c = x[r][i].z - mu, d = x[r][i].w - mu;
          q += a * a + b * b + c * c + d * d;
        }
        float rstd = rsqrtf(wave_sum(q) * (1.f / DM) + 1e-6f);
        const float* mod = (const float*)(P.ws + OFF_MOD) + ((size_t)l * 5 + row_cond(row)) * 6144;
#pragma unroll
        for (int i = 0; i < 8; ++i) {
          int c0 = (i * 64 + lane) * 4;
          float4 sh = *(const float4*)(mod + c0), sc = *(const float4*)(mod + 2048 + c0);
          h16x4 o;
          o[0] = (h16)((x[r][i].x - mu) * rstd * (1.f + sc.x) + sh.x);
          o[1] = (h16)((x[r][i].y - mu) * rstd * (1.f + sc.y) + sh.y);
          o[2] = (h16)((x[r][i].z - mu) * rstd * (1.f + sc.z) + sh.z);
          o[3] = (h16)((x[r][i].w - mu) * rstd * (1.f + sc.w) + sh.w);
          *(h16x4*)(U + (size_t)row * DM + c0) = o;
        }
      }
    }
  }
}

#define GLS 64
typedef __attribute__((ext_vector_type(4))) unsigned u32x4;
struct GStage { u32x4 w0, w1, w2, w3, u0, u1, u2, u3; };
__device__ __forceinline__ void g_load(GStage& S, const h16* gW, const h16* gU, int kt) {
  S.w0 = *(const u32x4*)(gW + (size_t)0 * 32 * DM + kt * 64);
  S.w1 = *(const u32x4*)(gW + (size_t)1 * 32 * DM + kt * 64);
  S.w2 = *(const u32x4*)(gW + (size_t)2 * 32 * DM + kt * 64);
  S.w3 = *(const u32x4*)(gW + (size_t)3 * 32 * DM + kt * 64);
  S.u0 = *(const u32x4*)(gU + (size_t)0 * 32 * DM + kt * 64);
  S.u1 = *(const u32x4*)(gU + (size_t)1 * 32 * DM + kt * 64);
  S.u2 = *(const u32x4*)(gU + (size_t)2 * 32 * DM + kt * 64);
  S.u3 = *(const u32x4*)(gU + (size_t)3 * 32 * DM + kt * 64);
}
__device__ __forceinline__ void g_store(const GStage& S, h16* sW, h16* sU, int buf, int ld_row, int ld_k) {
  const int pc = ((ld_k >> 3) ^ ((ld_row >> 1) & 7)) * 8;
  h16* w = sW + buf * 128 * GLS + ld_row * GLS + pc;
  h16* u = sU + buf * 128 * GLS + ld_row * GLS + pc;
  *(u32x4*)(w + 0 * 32 * GLS) = S.w0;
  *(u32x4*)(w + 1 * 32 * GLS) = S.w1;
  *(u32x4*)(w + 2 * 32 * GLS) = S.w2;
  *(u32x4*)(w + 3 * 32 * GLS) = S.w3;
  *(u32x4*)(u + 0 * 32 * GLS) = S.u0;
  *(u32x4*)(u + 1 * 32 * GLS) = S.u1;
  *(u32x4*)(u + 2 * 32 * GLS) = S.u2;
  *(u32x4*)(u + 3 * 32 * GLS) = S.u3;
}
__device__ __forceinline__ void g_compute(f32x4 (&acc)[4][4], const h16* cW, const h16* cU, int sw0) {
#pragma unroll
  for (int ks = 0; ks < 2; ++ks) {
    const int off = sw0 ^ (ks * 32);
    h16x8 a[4];
#pragma unroll
    for (int i = 0; i < 4; ++i) a[i] = *(const h16x8*)(cW + i * 16 * GLS + off);
    h16x8 bc = *(const h16x8*)(cU + off);
#pragma unroll
    for (int j = 0; j < 4; ++j) {
      h16x8 bn = bc;
      if (j < 3) bn = *(const h16x8*)(cU + (j + 1) * 16 * GLS + off);
      __builtin_amdgcn_sched_barrier(0);
#pragma unroll
      for (int i = 0; i < 4; ++i) acc[i][j] = mfma16(a[i], bc, acc[i][j]);
      __builtin_amdgcn_sched_barrier(0);
      bc = bn;
    }
  }
}
template <int EPI>
__device__ __forceinline__ void gemm_phase(const Params& P, int l, char* lds) {
  const int xcd = blockIdx.x & 7, lj = blockIdx.x >> 3;
  const int nchunk8 = (int)(gridDim.x >> 3);
  const h16* Wt = (EPI == 0) ? (const h16*)(P.ws + OFF_WTIN) + (size_t)l * NPAD * DM
                             : (const h16*)(P.ws + OFF_WTOUT) + (size_t)l * DM * DM;
  const h16* A = (const h16*)(P.ws + OFF_U);
  const int NTn = (EPI == 0) ? NPAD / 128 : DM / 128;
  const int ntiles = NTn * (MTOK / 128);
  h16* sW = (h16*)lds;
  h16* sU = sW + 2 * 128 * GLS;
  int tid = threadIdx.x;
  asm volatile("" : "+v"(tid));
  int lane = tid & 63, wave = tid >> 6;
  int wn = wave & 1, wm = wave >> 1;
  int lr = lane & 15, quad = lane >> 4;
  int ld_row = tid >> 3, ld_k = (tid & 7) * 8;
  const int sw0 = (quad ^ ((lr >> 1) & 7)) * 8;
  const int RN = (EPI == 0) ? 7 : 8;
  const int nrn = NTn / RN;
  for (int it = 0;; ++it) {
    int tile = (it * 8 + xcd) * nchunk8 + lj;
    if (tile >= ntiles) break;
    int rect = tile / (8 * RN), within = tile % (8 * RN);
    int mt = (rect / nrn) * 8 + (within & 7), nt = (rect % nrn) * RN + (within >> 3);
    int n0 = nt * 128, m0 = mt * 128;
    const h16* gW = Wt + (size_t)(n0 + ld_row) * DM + ld_k;
    const h16* gU = A + (size_t)(m0 + ld_row) * DM + ld_k;
    GStage stA, stB;
    f32x4 acc[4][4];
#pragma unroll
    for (int i = 0; i < 4; ++i)
#pragma unroll
      for (int j = 0; j < 4; ++j) acc[i][j] = (f32x4){0.f, 0.f, 0.f, 0.f};
    g_load(stB, gW, gU, 0);
    g_load(stA, gW, gU, 1);
    g_store(stB, sW, sU, 0, ld_row, ld_k);
    g_load(stB, gW, gU, 2);
    __syncthreads();
    for (int kt = 0; kt < 32; kt += 2) {
      g_store(stA, sW, sU, 1, ld_row, ld_k);
      __builtin_amdgcn_s_setprio(1);
      g_load(stA, gW, gU, min(kt + 3, 31));
      g_compute(acc, sW + (wn * 64 + lr) * GLS, sU + (wm * 64 + lr) * GLS, sw0);
      __builtin_amdgcn_s_setprio(0);
      __syncthreads();
      g_store(stB, sW, sU, 0, ld_row, ld_k);
      __builtin_amdgcn_s_setprio(1);
      g_load(stB, gW, gU, min(kt + 4, 31));
      g_compute(acc, sW + 128 * GLS + (wn * 64 + lr) * GLS, sU + 128 * GLS + (wm * 64 + lr) * GLS, sw0);
      __builtin_amdgcn_s_setprio(0);
      __syncthreads();
    }
    if (EPI == 0) {
      bool lat = (m0 >= MCTX);
      if (lat && n0 < C_VA) {
        const float2* rope = (const float2*)(P.ws + OFF_ROPE);
#pragma unroll
        for (int j = 0; j < 4; ++j) {
          int m = m0 + wm * 64 + j * 16 + lr;
          int t = (m - MCTX) & 1023;
#pragma unroll
          for (int i = 0; i < 2; ++i)
#pragma unroll
            for (int jj = 0; jj < 4; ++jj) {
              float2 cs = rope[t * 64 + wn * 32 + i * 16 + quad * 4 + jj];
              float x1 = acc[i][j][jj], x2 = acc[i + 2][j][jj];
              acc[i][j][jj] = x1 * cs.x - x2 * cs.y;
              acc[i + 2][j][jj] = x1 * cs.y + x2 * cs.x;
            }
        }
      }
      h16* proj = (h16*)(P.ws + OFF_PROJ);
#pragma unroll
      for (int i = 0; i < 4; ++i) {
        int n = n0 + wn * 64 + i * 16 + quad * 4;
        if (n >= DPROJ) continue;
        bool isVa = (n >= C_VA && n < C_GA);
        bool isVd = (n >= C_VD && n < C_GD);
#pragma unroll
        for (int j = 0; j < 4; ++j) {
          int m = m0 + wm * 64 + j * 16 + lr;
          f32x4 v = acc[i][j];
          if (isVa || isVd) {
            int nn = isVa ? n - C_VA : n - C_VD;
            h16* dst;
            int T, t;
            if (!lat) {
              int b = m >> 8; t = m & 255; T = 256;
              dst = isVa ? (h16*)(P.ws + OFF_VTA_CTX) + ((size_t)b * 256 + nn) * 256
                         : (h16*)(P.ws + OFF_VTD_CTX) + ((size_t)b * 512 + nn) * 256;
            } else {
              int b = (m - MCTX) >> 10; t = (m - MCTX) & 1023; T = 1024;
              dst = isVa ? (h16*)(P.ws + OFF_VTA_LAT) + ((size_t)b * 256 + nn) * 1024
                         : (h16*)(P.ws + OFF_VTD_LAT) + ((size_t)b * 512 + nn) * 1024;
            }
#pragma unroll
            for (int jj = 0; jj < 4; ++jj) dst[(size_t)jj * T + t] = (h16)v[jj];
          } else {
            *(h16x4*)(proj + (size_t)m * DPROJ + n) = pack4(v);
          }
          if (!lat) {
            int b = m >> 8, t = m & 255;
            size_t r = ((size_t)(b * 2 + l) * 256 + t);
            float* o = nullptr;
            if (n >= C_KA && n < C_VA) o = P.out + O_NAK + r * 256 + (n - C_KA);
            else if (isVa) o = P.out + O_NAV + r * 256 + (n - C_VA);
            else if (n >= C_KD && n < C_VD) o = P.out + O_NNK + r * 512 + (n - C_KD);
            else if (isVd) o = P.out + O_NNV + r * 512 + (n - C_VD);
            if (o) *(float4*)o = make_float4(v[0], v[1], v[2], v[3]);
          }
        }
      }
    } else {
      const float alpha = 1.41421356237f;
      float* y = P.out + O_Y;
#pragma unroll
      for (int i = 0; i < 4; ++i) {
        int n = n0 + wn * 64 + i * 16 + quad * 4;
#pragma unroll
        for (int j = 0; j < 4; ++j) {
          int m = m0 + wm * 64 + j * 16 + lr;
          const float* xs;
          if (l == 0) xs = (m < MCTX) ? P.in[I_XP] + (size_t)m * DM : P.in[I_XS] + (size_t)(m - MCTX) * DM;
          else xs = y + (size_t)m * DM;
          float4 xv = *(const float4*)(xs + n);
          float4 g = *(const float4*)((const float*)(P.ws + OFF_MOD) + ((size_t)l * 5 + row_cond(m)) * 6144 + 4096 + n);
          f32x4 v = acc[i][j];
          float4 o = make_float4(alpha * xv.x + g.x * v[0], alpha * xv.y + g.y * v[1], alpha * xv.z + g.z * v[2],
                                 alpha * xv.w + g.w * v[3]);
          *(float4*)(y + (size_t)m * DM + n) = o;
        }
      }
    }
  }
}

struct JStage { u32x4 w0, w1, w2, w3, u0, u1, u2, u3, u4, u5, u6, u7; };
__device__ __forceinline__ u32x4 ldg_so(const h16* ubase, unsigned boff) {
  return *(const u32x4*)((const char*)ubase + boff);
}
__device__ __forceinline__ void j_load(JStage& S, const h16* Wk, const h16* Uk, unsigned voff) {
  S.w0 = ldg_so(Wk, voff + 0u * 131072u);
  S.w1 = ldg_so(Wk, voff + 1u * 131072u);
  S.w2 = ldg_so(Wk, voff + 2u * 131072u);
  S.w3 = ldg_so(Wk, voff + 3u * 131072u);
  S.u0 = ldg_so(Uk, voff + 0u * 131072u);
  S.u1 = ldg_so(Uk, voff + 1u * 131072u);
  S.u2 = ldg_so(Uk, voff + 2u * 131072u);
  S.u3 = ldg_so(Uk, voff + 3u * 131072u);
  S.u4 = ldg_so(Uk, voff + 4u * 131072u);
  S.u5 = ldg_so(Uk, voff + 5u * 131072u);
  S.u6 = ldg_so(Uk, voff + 6u * 131072u);
  S.u7 = ldg_so(Uk, voff + 7u * 131072u);
}
__device__ __forceinline__ void j_store(const JStage& S, h16* sW, h16* sU, int ld_row, int pc) {
  h16* w = sW + ld_row * 64 + pc;
  h16* u = sU + ld_row * 64 + pc;
  *(u32x4*)(w + 0 * 2048) = S.w0;
  *(u32x4*)(w + 1 * 2048) = S.w1;
  *(u32x4*)(w + 2 * 2048) = S.w2;
  *(u32x4*)(w + 3 * 2048) = S.w3;
  *(u32x4*)(u + 0 * 2048) = S.u0;
  *(u32x4*)(u + 1 * 2048) = S.u1;
  *(u32x4*)(u + 2 * 2048) = S.u2;
  *(u32x4*)(u + 3 * 2048) = S.u3;
  *(u32x4*)(u + 4 * 2048) = S.u4;
  *(u32x4*)(u + 5 * 2048) = S.u5;
  *(u32x4*)(u + 6 * 2048) = S.u6;
  *(u32x4*)(u + 7 * 2048) = S.u7;
}
__device__ __forceinline__ void j_compute(f32x4 (&acc)[4][8], const h16* cW, const h16* cU, int sw0) {
#pragma unroll
  for (int ks = 0; ks < 2; ++ks) {
    const int off = sw0 ^ (ks * 32);
    h16x8 a[4];
#pragma unroll
    for (int i = 0; i < 4; ++i) a[i] = *(const h16x8*)(cW + i * 16 * 64 + off);
    h16x8 b0 = *(const h16x8*)(cU + off);
    h16x8 b1 = *(const h16x8*)(cU + 1 * 16 * 64 + off);
#pragma unroll
    for (int j = 0; j < 8; ++j) {
      h16x8 b2 = b1;
      if (j < 6) b2 = *(const h16x8*)(cU + (j + 2) * 16 * 64 + off);
      __builtin_amdgcn_sched_barrier(0);
#pragma unroll
      for (int i = 0; i < 4; ++i) acc[i][j] = mfma16(a[i], b0, acc[i][j]);
      __builtin_amdgcn_sched_barrier(0);
      b0 = b1;
      b1 = b2;
    }
  }
}
__device__ __forceinline__ void gemm_in_phase(const Params& P, int l, char* lds) {
  const int xcd = blockIdx.x & 7, lj = blockIdx.x >> 3;
  const int nchunk8 = (int)(gridDim.x >> 3);
  const h16* Wt = (const h16*)(P.ws + OFF_WTIN) + (size_t)l * NPAD * DM;
  const h16* A = (const h16*)(P.ws + OFF_U);
  const int NTn = NPAD / 128;
  const int ntiles = NTn * (MTOK / 256);
  h16* sW = (h16*)lds;
  h16* sU = sW + 128 * 64;
  int tid = threadIdx.x;
  asm volatile("" : "+v"(tid));
  int lane = tid & 63, wave = tid >> 6;
  int wn = wave & 1, wm = wave >> 1;
  int lr = lane & 15, quad = lane >> 4;
  int ld_row = tid >> 3, ld_k = (tid & 7) * 8;
  const int pc = ((tid & 7) ^ ((ld_row >> 1) & 7)) * 8;
  const int sw0 = (quad ^ ((lr >> 1) & 7)) * 8;
  const int RN = 7, nrn = NTn / RN;
  for (int it = 0;; ++it) {
    int tile = (it * 8 + xcd) * nchunk8 + lj;
    if (tile >= ntiles) break;
    int rect = tile / (8 * RN), within = tile % (8 * RN);
    int mt = (rect / nrn) * 8 + (within & 7), nt = (rect % nrn) * RN + (within >> 3);
    int n0 = nt * 128, m0 = mt * 256;
    const h16* gW = Wt + (size_t)n0 * DM;
    const h16* gU = A + (size_t)m0 * DM;
    const unsigned voff = (unsigned)(ld_row * DM + ld_k) * 2u;
    JStage S;
    f32x4 acc[4][8];
#pragma unroll
    for (int i = 0; i < 4; ++i)
#pragma unroll
      for (int j = 0; j < 8; ++j) acc[i][j] = (f32x4){0.f, 0.f, 0.f, 0.f};
    j_load(S, gW, gU, voff);
    j_store(S, sW, sU, ld_row, pc);
    __syncthreads();
    const h16* cW = sW + (wn * 64 + lr) * 64;
    const h16* cU = sU + (wm * 128 + lr) * 64;
    for (int kt = 0; kt < 32; ++kt) {
      __builtin_amdgcn_s_setprio(1);
      { const int kn = min(kt + 1, 31) * 64; j_load(S, gW + kn, gU + kn, voff); }
      j_compute(acc, cW, cU, sw0);
      __builtin_amdgcn_s_setprio(0);
      __syncthreads();
      j_store(S, sW, sU, ld_row, pc);
      __syncthreads();
    }
    {
      bool lat = (m0 >= MCTX);
      if (lat && n0 < C_VA) {
        const float2* rope = (const float2*)(P.ws + OFF_ROPE);
#pragma unroll
        for (int j = 0; j < 8; ++j) {
          int m = m0 + wm * 128 + j * 16 + lr;
          int t = (m - MCTX) & 1023;
#pragma unroll
          for (int i = 0; i < 2; ++i)
#pragma unroll
            for (int jj = 0; jj < 4; ++jj) {
              float2 cs = rope[t * 64 + wn * 32 + i * 16 + quad * 4 + jj];
              float x1 = acc[i][j][jj], x2 = acc[i + 2][j][jj];
              acc[i][j][jj] = x1 * cs.x - x2 * cs.y;
              acc[i + 2][j][jj] = x1 * cs.y + x2 * cs.x;
            }
        }
      }
      h16* proj = (h16*)(P.ws + OFF_PROJ);
#pragma unroll
      for (int i = 0; i < 4; ++i) {
        int n = n0 + wn * 64 + i * 16 + quad * 4;
        if (n >= DPROJ) continue;
        bool isVa = (n >= C_VA && n < C_GA);
        bool isVd = (n >= C_VD && n < C_GD);
#pragma unroll
        for (int j = 0; j < 8; ++j) {
          int m = m0 + wm * 128 + j * 16 + lr;
          f32x4 v = acc[i][j];
          if (isVa || isVd) {
            int nn = isVa ? n - C_VA : n - C_VD;
            h16* dst;
            int T, t;
            if (!lat) {
              int b = m >> 8; t = m & 255; T = 256;
              dst = isVa ? (h16*)(P.ws + OFF_VTA_CTX) + ((size_t)b * 256 + nn) * 256
                         : (h16*)(P.ws + OFF_VTD_CTX) + ((size_t)b * 512 + nn) * 256;
            } else {
              int b = (m - MCTX) >> 10; t = (m - MCTX) & 1023; T = 1024;
              dst = isVa ? (h16*)(P.ws + OFF_VTA_LAT) + ((size_t)b * 256 + nn) * 1024
                         : (h16*)(P.ws + OFF_VTD_LAT) + ((size_t)b * 512 + nn) * 1024;
            }
#pragma unroll
            for (int jj = 0; jj < 4; ++jj) dst[(size_t)jj * T + t] = (h16)v[jj];
          } else {
            *(h16x4*)(proj + (size_t)m * DPROJ + n) = pack4(v);
          }
          if (!lat) {
            int b = m >> 8, t = m & 255;
            size_t r = ((size_t)(b * 2 + l) * 256 + t);
            float* o = nullptr;
            if (n >= C_KA && n < C_VA) o = P.out + O_NAK + r * 256 + (n - C_KA);
            else if (isVa) o = P.out + O_NAV + r * 256 + (n - C_VA);
            else if (n >= C_KD && n < C_VD) o = P.out + O_NNK + r * 512 + (n - C_KD);
            else if (isVd) o = P.out + O_NNV + r * 512 + (n - C_VD);
            if (o) *(float4*)o = make_float4(v[0], v[1], v[2], v[3]);
          }
        }
      }
    }
  }
}

#define KLS 136
#define VLS 72
__device__ __forceinline__ void attn_unit(const Params& P, int l, int mode, int b, int h, int qt, char* lds) {
  h16* sK0 = (h16*)lds;
  h16* sVT0 = sK0 + 2 * 64 * KLS;
  float* sRpb = (float*)(sVT0 + 2 * 128 * VLS);
  int tid = threadIdx.x;
  asm volatile("" : "+v"(tid));
  int lane = tid & 63, wave = tid >> 6;
  int lr = lane & 15, quad = lane >> 4;
  const bool isA = (mode == 0 || mode == 2);
  const bool lat = (mode >= 2);
  const int T = lat ? 1024 : 256;
  const int rowbase = lat ? MCTX + b * 1024 : b * 256;
  const int qcol = isA ? C_QA : C_QD, kcol = isA ? C_KA : C_KD, gcol = isA ? C_GA : C_GD, ocol = isA ? 0 : 1536;
  const int nkv = isA ? 2 : 4;
  const int kvh = isA ? (h >> 1) : h;
  const h16* proj = (const h16*)(P.ws + OFF_PROJ);
  const h16* Kown = proj + (size_t)rowbase * DPROJ + kcol + kvh * 128;
  const h16* VTown = (const h16*)(P.ws + (isA ? (lat ? OFF_VTA_LAT : OFF_VTA_CTX) : (lat ? OFF_VTD_LAT : OFF_VTD_CTX))) +
                     ((size_t)(b * nkv + kvh) * 128) * T;
  const h16* Kc = (const h16*)(P.ws + (isA ? OFF_KCA : OFF_KCD)) + ((size_t)(b * 2 + l) * 256) * (nkv * 128) + kvh * 128;
  const h16* VTc = (const h16*)(P.ws + (isA ? OFF_VTAC : OFF_VTDC)) + ((size_t)((b * 2 + l) * nkv + kvh) * 128) * 256;
  const int q0 = qt * 64;
  int n0t, start0;
  if (mode < 2) { n0t = 4; start0 = 0; }
  else if (mode == 2) {
    int lo = q0 - 128; if (lo < 0) lo = 0;
    int hi = q0 + 192; if (hi > T) hi = T;
    start0 = lo; n0t = (hi - lo) >> 6;
  } else {
    int rs = qt - 4; if (rs < 0) rs = 0; if (rs > 8) rs = 8;
    start0 = rs * 64; n0t = 8;
  }
  const int ntot = n0t + (lat ? 4 : 0);
  __syncthreads();
  if (mode == 3) {
    const float* rpb = P.in[I_RPB] + ((size_t)l * 4 + h) * 15 * 31;
    for (int i = tid; i < 15 * 31; i += NTHREADS) sRpb[i] = rpb[i];
  }
  const int qi = wave * 16 + lr;
  const h16* qrow = proj + (size_t)(rowbase + q0 + qi) * DPROJ + qcol + h * 128 + quad * 8;
  h16x8 qf[4];
#pragma unroll
  for (int ks = 0; ks < 4; ++ks) qf[ks] = *(const h16x8*)(qrow + ks * 32);
  const float scale = 0.08838834764831845f;
  float m_run = -1e30f, l_run = 0.f;
  f32x4 O[8];
#pragma unroll
  for (int d = 0; d < 8; ++d) O[d] = (f32x4){0.f, 0.f, 0.f, 0.f};
  const int qpos = q0 + qi;
  const int qc = qi;
  int cs = qc - 8; if (cs < 0) cs = 0; if (cs > 48) cs = 48;

  u32x4 rk0, rk1, rk2, rk3, rv0, rv1, rv2, rv3;
  const int kr = tid >> 4, kch = (tid & 15) * 8;
  const int vr = tid >> 3, vch = (tid & 7) * 8;
#define ATT_LOAD(IT)                                                                              \
  {                                                                                               \
    const bool own_ = (IT) < n0t;                                                                 \
    const int ks_ = own_ ? start0 + (IT) * 64 : ((IT) - n0t) * 64;                                \
    const h16* Kp_ = own_ ? Kown + (size_t)ks_ * DPROJ : Kc + (size_t)ks_ * (nkv * 128);          \
    const size_t kst_ = own_ ? DPROJ : nkv * 128;                                                 \
    const h16* Vp_ = own_ ? VTown + ks_ : VTc + ks_;                                              \
    const size_t vst_ = own_ ? T : 256;                                                           \
    rk0 = *(const u32x4*)(Kp_ + (size_t)(kr) * kst_ + kch);                                       \
    rk1 = *(const u32x4*)(Kp_ + (size_t)(kr + 16) * kst_ + kch);                                  \
    rk2 = *(const u32x4*)(Kp_ + (size_t)(kr + 32) * kst_ + kch);                                  \
    rk3 = *(const u32x4*)(Kp_ + (size_t)(kr + 48) * kst_ + kch);                                  \
    rv0 = *(const u32x4*)(Vp_ + (size_t)(vr) * vst_ + vch);                                       \
    rv1 = *(const u32x4*)(Vp_ + (size_t)(vr + 32) * vst_ + vch);                                  \
    rv2 = *(const u32x4*)(Vp_ + (size_t)(vr + 64) * vst_ + vch);                                  \
    rv3 = *(const u32x4*)(Vp_ + (size_t)(vr + 96) * vst_ + vch);                                  \
  }
#define ATT_STORE(BUF)                                                        \
  {                                                                           \
    h16* k_ = sK0 + (BUF) * 64 * KLS + kr * KLS + kch;                        \
    h16* v_ = sVT0 + (BUF) * 128 * VLS + vr * VLS + vch;                      \
    *(u32x4*)(k_) = rk0; *(u32x4*)(k_ + 16 * KLS) = rk1;                      \
    *(u32x4*)(k_ + 32 * KLS) = rk2; *(u32x4*)(k_ + 48 * KLS) = rk3;           \
    *(u32x4*)(v_) = rv0; *(u32x4*)(v_ + 32 * VLS) = rv1;                      \
    *(u32x4*)(v_ + 64 * VLS) = rv2; *(u32x4*)(v_ + 96 * VLS) = rv3;           \
  }
  ATT_LOAD(0);
  ATT_STORE(0);
  if (ntot > 1) ATT_LOAD(1);
  __syncthreads();
  for (int it = 0; it < ntot; ++it) {
    const bool own = it < n0t;
    const int kstart = own ? start0 + it * 64 : (it - n0t) * 64;
    if (it + 1 < ntot) ATT_STORE((it + 1) & 1);
    if (it + 2 < ntot) ATT_LOAD(it + 2);
    const h16* sK = sK0 + (it & 1) * 64 * KLS;
    const h16* sVT = sVT0 + (it & 1) * 128 * VLS;
    f32x4 s[4];
#pragma unroll
    for (int kf = 0; kf < 4; ++kf) {
      s[kf] = (f32x4){0.f, 0.f, 0.f, 0.f};
#pragma unroll
      for (int ks = 0; ks < 4; ++ks) {
        h16x8 a = *(const h16x8*)(sK + (kf * 16 + lr) * KLS + ks * 32 + quad * 8);
        s[kf] = mfma16(a, qf[ks], s[kf]);
      }
    }
    float mx = -1e30f;
#pragma unroll
    for (int kf = 0; kf < 4; ++kf)
#pragma unroll
      for (int jj = 0; jj < 4; ++jj) {
        float v = s[kf][jj] * scale;
        int kk = kf * 16 + quad * 4 + jj;
        if (own && mode == 2) {
          int d = kstart + kk - qpos;
          if (d > 128 || d < -128) v = -1e30f;
        } else if (own && mode == 3) {
          if (kk >= cs && kk < cs + 16) {
            int dy = (kstart >> 6) - qt;
            int dx = kk - qc; if (dx < -15) dx = -15; if (dx > 15) dx = 15;
            v += sRpb[(dy + 7) * 31 + dx + 15];
          } else v = -1e30f;
        }
        s[kf][jj] = v;
        mx = fmaxf(mx, v);
      }
    mx = fmaxf(mx, __shfl_xor(mx, 16));
    mx = fmaxf(mx, __shfl_xor(mx, 32));
    float m_new = fmaxf(m_run, mx);
    float alpha = __expf(m_run - m_new);
    float psum = 0.f;
#pragma unroll
    for (int kf = 0; kf < 4; ++kf)
#pragma unroll
      for (int jj = 0; jj < 4; ++jj) {
        float p = __expf(s[kf][jj] - m_new);
        s[kf][jj] = p;
        psum += p;
      }
    l_run = l_run * alpha + psum;
    m_run = m_new;
#pragma unroll
    for (int d = 0; d < 8; ++d) { O[d][0] *= alpha; O[d][1] *= alpha; O[d][2] *= alpha; O[d][3] *= alpha; }
#pragma unroll
    for (int kk2 = 0; kk2 < 2; ++kk2) {
      h16x8 pb = pack8(s[2 * kk2], s[2 * kk2 + 1]);
#pragma unroll
      for (int d = 0; d < 8; ++d) {
        const h16* vr = sVT + (d * 16 + lr) * VLS + quad * 4;
        h16x8 a = read_split(vr + (2 * kk2) * 16, vr + (2 * kk2 + 1) * 16);
        O[d] = mfma16(a, pb, O[d]);
      }
    }
    __syncthreads();
  }
#undef ATT_LOAD
#undef ATT_STORE
  l_run += __shfl_xor(l_run, 16);
  l_run += __shfl_xor(l_run, 32);
  if (isA) l_run += __expf(P.in[I_SINK][l * 4 + h] - m_run);
  float inv = 1.f / l_run;
  const size_t row = (size_t)(rowbase + q0 + qi);
  const h16* grow = proj + row * DPROJ + gcol + h * 128;
  h16* orow = (h16*)(P.ws + OFF_U) + row * DM + ocol + h * 128;
#pragma unroll
  for (int d = 0; d < 8; ++d) {
    int dd = d * 16 + quad * 4;
    h16x4 g = *(const h16x4*)(grow + dd);
    h16x4 o;
#pragma unroll
    for (int jj = 0; jj < 4; ++jj) o[jj] = (h16)(O[d][jj] * inv * silu_f((float)g[jj]));
    *(h16x4*)(orow + dd) = o;
  }
}

__device__ __forceinline__ void conv_load(const Params& P, int l, int row0, int T, int t0, int ntok, int xcol, int ncols, h16* dst,
                          int dstride, bool transposed) {
  const h16* proj = (const h16*)(P.ws + OFF_PROJ);
  const float* cw = P.in[I_CONVW] + (size_t)l * 5 * 1024;
  const float* cb = P.in[I_CONVB] + (size_t)l * 1024;
  int tid0 = threadIdx.x;
  asm volatile("" : "+v"(tid0));
  int gpt = ncols >> 3;
  int total = ntok * gpt;
#pragma unroll 1
  for (int idx = tid0; idx < total; idx += NTHREADS) {
    int tl = idx / gpt, c = (idx % gpt) * 8;
    int t = t0 + tl;
    float acc[8];
    {
      float4 b0 = *(const float4*)(cb + xcol + c), b1 = *(const float4*)(cb + xcol + c + 4);
      acc[0] = b0.x; acc[1] = b0.y; acc[2] = b0.z; acc[3] = b0.w;
      acc[4] = b1.x; acc[5] = b1.y; acc[6] = b1.z; acc[7] = b1.w;
    }
#pragma unroll
    for (int k = 0; k < 5; ++k) {
      int tt = t + k - 2;
      if (tt >= 0 && tt < T) {
        h16x8 x = *(const h16x8*)(proj + (size_t)(row0 + tt) * DPROJ + C_XBC + xcol + c);
        float4 w0 = *(const float4*)(cw + k * 1024 + xcol + c), w1 = *(const float4*)(cw + k * 1024 + xcol + c + 4);
        acc[0] += w0.x * (float)x[0]; acc[1] += w0.y * (float)x[1]; acc[2] += w0.z * (float)x[2]; acc[3] += w0.w * (float)x[3];
        acc[4] += w1.x * (float)x[4]; acc[5] += w1.y * (float)x[5]; acc[6] += w1.z * (float)x[6]; acc[7] += w1.w * (float)x[7];
      }
    }
    h16x8 o;
#pragma unroll
    for (int e = 0; e < 8; ++e) o[e] = (h16)silu_f(acc[e]);
    if (!transposed) *(h16x8*)(dst + tl * dstride + c) = o;
    else {
#pragma unroll
      for (int e = 0; e < 8; ++e) dst[(c + e) * dstride + tl] = o[e];
    }
  }
}

__device__ __forceinline__ float softplus_f(float x) { return x > 20.f ? x : log1pf(__expf(x)); }

__device__ __forceinline__ void chunk_scan(const Params& P, int l, int row_chunk0, int dir, int h, int lane, float& dt0,
                                           float& dt1, float& L0, float& L1, int& tk0, int& tk1) {
  const h16* proj = (const h16*)(P.ws + OFF_PROJ);
  float bias = P.in[I_DTB][(l * 2 + dir) * 8 + h];
  float A = -__expf(P.in[I_ALOG][(l * 2 + dir) * 8 + h]);
  int e0 = 2 * lane, e1 = 2 * lane + 1;
  tk0 = dir ? 127 - e0 : e0;
  tk1 = dir ? 127 - e1 : e1;
  dt0 = softplus_f((float)proj[(size_t)(row_chunk0 + tk0) * DPROJ + C_DT + dir * 8 + h] + bias);
  dt1 = softplus_f((float)proj[(size_t)(row_chunk0 + tk1) * DPROJ + C_DT + dir * 8 + h] + bias);
  float a0 = dt0 * A, a1 = dt1 * A;
  float s = a0 + a1;
  float inc = s;
#pragma unroll
  for (int o = 1; o < 64; o <<= 1) {
    float v = __shfl_up(inc, o);
    if (lane >= o) inc += v;
  }
  float excl = inc - s;
  L0 = excl + a0;
  L1 = excl + a0 + a1;
}

#define TLS 1032
__device__ __forceinline__ void conv_unit(const Params& P, int l, int tile, char* lds) {
  int tid = threadIdx.x;
  asm volatile("" : "+v"(tid));
  const int rowt = tile * 32;
  const bool lat = rowt >= MCTX;
  const int T = lat ? 1024 : 256;
  const int row0 = lat ? MCTX + (((rowt - MCTX) >> 10) << 10) : (rowt >> 8) << 8;
  const int t0 = rowt - row0;
  h16* tileS = (h16*)lds;
  const h16* proj = (const h16*)(P.ws + OFF_PROJ);
  const int c = (tid & 127) * 8, half = tid >> 7;
  const float* cw = P.in[I_CONVW] + (size_t)l * 5 * 1024 + c;
  const float* cb = P.in[I_CONVB] + (size_t)l * 1024 + c;
  float w[5][8], bias[8];
#pragma unroll
  for (int k = 0; k < 5; ++k) {
    float4 a = *(const float4*)(cw + k * 1024), b4 = *(const float4*)(cw + k * 1024 + 4);
    w[k][0] = a.x; w[k][1] = a.y; w[k][2] = a.z; w[k][3] = a.w; w[k][4] = b4.x; w[k][5] = b4.y; w[k][6] = b4.z; w[k][7] = b4.w;
  }
  {
    float4 a = *(const float4*)cb, b4 = *(const float4*)(cb + 4);
    bias[0] = a.x; bias[1] = a.y; bias[2] = a.z; bias[3] = a.w; bias[4] = b4.x; bias[5] = b4.y; bias[6] = b4.z; bias[7] = b4.w;
  }
  __syncthreads();
#pragma unroll
  for (int part = 0; part < 2; ++part) {
    const int tb = t0 + half * 16 + part * 8;
    h16x8 xr[12];
#pragma unroll
    for (int r = 0; r < 12; ++r) {
      int tt = tb + r - 2;
      h16x8 z = {0, 0, 0, 0, 0, 0, 0, 0};
      xr[r] = (tt >= 0 && tt < T) ? *(const h16x8*)(proj + (size_t)(row0 + tt) * DPROJ + C_XBC + c) : z;
    }
#pragma unroll
    for (int i = 0; i < 8; ++i) {
      float acc[8];
#pragma unroll
      for (int e = 0; e < 8; ++e) acc[e] = bias[e];
#pragma unroll
      for (int k = 0; k < 5; ++k)
#pragma unroll
        for (int e = 0; e < 8; ++e) acc[e] += w[k][e] * (float)xr[i + k][e];
      h16x8 o;
#pragma unroll
      for (int e = 0; e < 8; ++e) o[e] = (h16)silu_f(acc[e]);
      *(h16x8*)(tileS + (half * 16 + part * 8 + i) * TLS + c) = o;
    }
  }
  __syncthreads();
  h16* xbcn = (h16*)(P.ws + OFF_XBCN);
#pragma unroll
  for (int i = 0; i < 8; ++i) {
    int idx = tid + i * 256;
    int r = idx >> 6, ch = (idx & 63) * 8;
    *(uint4*)(xbcn + (size_t)(rowt + r) * 512 + ch) = *(const uint4*)(tileS + r * TLS + 512 + ch);
  }
  h16* xt = (h16*)(P.ws + OFF_XT) + (size_t)row0 * 512 + t0;
  h16* bt = (h16*)(P.ws + OFF_BT) + (size_t)row0 * 256 + t0;
#pragma unroll
  for (int i = 0; i < 3; ++i) {
    int ch = tid + i * 256;
    h16* dst = (ch < 512) ? xt + (size_t)ch * T : bt + (size_t)(ch - 512) * T;
#pragma unroll
    for (int q = 0; q < 4; ++q) {
      h16x8 o;
#pragma unroll
      for (int e = 0; e < 8; ++e) o[e] = tileS[(q * 8 + e) * TLS + ch];
      *(h16x8*)(dst + q * 8) = o;
    }
  }
}

__device__ __forceinline__ void conv_phase(const Params& P, int l, char* lds) {
  const int U_CONV = 384, U_SCAN = 384;
  for (int u = blockIdx.x; u < U_CONV + U_SCAN; u += gridDim.x) {
    if (u < U_CONV) { conv_unit(P, l, u, lds); continue; }
    int tid = threadIdx.x;
    asm volatile("" : "+v"(tid));
    int lane = tid & 63, wave = tid >> 6;
    int wt = (u - U_CONV) * 4 + wave;
    int bc = wt >> 4, combo = wt & 15;
    int h = combo >> 1, dir = combo & 1;
    int rowc = (bc < 64) ? (bc >> 1) * 256 + (bc & 1) * 128 : MCTX + ((bc - 64) >> 3) * 1024 + ((bc - 64) & 7) * 128;
    float d0, d1, L0, L1; int k0, k1;
    chunk_scan(P, l, rowc, dir, h, lane, d0, d1, L0, L1, k0, k1);
    float* DT = (float*)(P.ws + OFF_DT) + (size_t)wt * 128;
    float* LL = (float*)(P.ws + OFF_LL) + (size_t)wt * 128;
    DT[k0] = d0; DT[k1] = d1; LL[k0] = L0; LL[k1] = L1;
    if (lane == 63) ((float*)(P.ws + OFF_CDEC))[wt] = __expf(L1);
  }
}

__device__ __forceinline__ void ssd_intra_unit(const Params& P, int l, bool lat, int b, int c, int h, char* lds) {
  const int T = lat ? 1024 : 256;
  const int row0 = lat ? MCTX + b * 1024 : b * 256;
  const int t0 = c * 128;
  const int bc = lat ? 64 + b * 8 + c : b * 2 + c;
  const int g = h >> 2;
  int tid = threadIdx.x;
  asm volatile("" : "+v"(tid));
  int lane = tid & 63, wave = tid >> 6;
  int lr = lane & 15, quad = lane >> 4;
  h16* sC = (h16*)lds;
  h16* sB = sC + 128 * KLS;
  float* fL = (float*)(lds + 69632);
  float* Lf = fL, *Lb = fL + 128, *dtf = fL + 256, *dtb = fL + 384, *wf = fL + 512, *wb = fL + 640;
  h16* sXT = (h16*)lds;
  h16* sBT = sXT + 64 * KLS;
  __syncthreads();
  const h16* xbcn = (const h16*)(P.ws + OFF_XBCN) + (size_t)(row0 + t0) * 512;
  u32x4 rc[8], rb[8];
#pragma unroll
  for (int i = 0; i < 8; ++i) {
    int idx = tid + i * 256;
    int r = idx >> 4, ch = (idx & 15) * 8;
    rc[i] = *(const u32x4*)(xbcn + (size_t)r * 512 + 256 + g * 128 + ch);
    rb[i] = *(const u32x4*)(xbcn + (size_t)r * 512 + g * 128 + ch);
  }
  if (tid < 128) {
    const float* DT = (const float*)(P.ws + OFF_DT) + (size_t)(bc * 16 + h * 2) * 128;
    const float* LL = (const float*)(P.ws + OFF_LL) + (size_t)(bc * 16 + h * 2) * 128;
    float lf = LL[tid], lb = LL[128 + tid], df = DT[tid], db = DT[128 + tid];
    float lfe = LL[127], lbe = LL[128];
    Lf[tid] = lf; Lb[tid] = lb; dtf[tid] = df; dtb[tid] = db;
    wf[tid] = __expf(lfe - lf) * df;
    wb[tid] = __expf(lbe - lb) * db;
  }
#pragma unroll
  for (int i = 0; i < 8; ++i) {
    int idx = tid + i * 256;
    int r = idx >> 4, ch = (idx & 15) * 8;
    *(u32x4*)(sC + r * KLS + ch) = rc[i];
    *(u32x4*)(sB + r * KLS + ch) = rb[i];
  }
  const h16* xtg = (const h16*)(P.ws + OFF_XT) + (size_t)row0 * 512 + (size_t)(h * 64) * T + t0;
  const h16* btg = (const h16*)(P.ws + OFF_BT) + (size_t)row0 * 256 + (size_t)(g * 128) * T + t0;
  u32x4 rx[4], rt[8];
#pragma unroll
  for (int i = 0; i < 4; ++i) {
    int idx = tid + i * 256;
    int r = idx >> 4, ch = (idx & 15) * 8;
    rx[i] = *(const u32x4*)(xtg + (size_t)r * T + ch);
  }
#pragma unroll
  for (int i = 0; i < 8; ++i) {
    int idx = tid + i * 256;
    int r = idx >> 4, ch = (idx & 15) * 8;
    rt[i] = *(const u32x4*)(btg + (size_t)r * T + ch);
  }
  __syncthreads();
  f32x4 acc[8][2];
#pragma unroll
  for (int jf = 0; jf < 8; ++jf) { acc[jf][0] = (f32x4){0.f, 0.f, 0.f, 0.f}; acc[jf][1] = (f32x4){0.f, 0.f, 0.f, 0.f}; }
#pragma unroll
  for (int ks = 0; ks < 4; ++ks) {
    h16x8 bo[2];
#pragma unroll
    for (int f = 0; f < 2; ++f) bo[f] = *(const h16x8*)(sC + (wave * 32 + f * 16 + lr) * KLS + ks * 32 + quad * 8);
#pragma unroll
    for (int jf = 0; jf < 8; ++jf) {
      h16x8 a = *(const h16x8*)(sB + (jf * 16 + lr) * KLS + ks * 32 + quad * 8);
      acc[jf][0] = mfma16(a, bo[0], acc[jf][0]);
      acc[jf][1] = mfma16(a, bo[1], acc[jf][1]);
    }
  }
  h16x8 mb[4][2];
  {
    const int i0 = wave * 32 + lr, i1 = wave * 32 + 16 + lr;
    const float Lfi0 = Lf[i0], Lbi0 = Lb[i0], Lfi1 = Lf[i1], Lbi1 = Lb[i1];
    const int dji = quad * 4 - i0;
#pragma unroll
    for (int kk = 0; kk < 4; ++kk) {
#pragma unroll
      for (int hf = 0; hf < 2; ++hf) {
        const int jf = 2 * kk + hf;
        const int jb = jf * 16 + quad * 4;
        f32x4 lfj = *(const f32x4*)(Lf + jb), lbj = *(const f32x4*)(Lb + jb);
        f32x4 dfj = *(const f32x4*)(dtf + jb), dbj = *(const f32x4*)(dtb + jb);
#pragma unroll
        for (int jj = 0; jj < 4; ++jj) {
          int t0_ = dji + jf * 16 + jj, t1_ = t0_ - 16;
          float mf0 = (float)((unsigned)(t0_ - 1) >> 31), mb0 = (float)((unsigned)(-t0_ - 1) >> 31);
          float mf1 = (float)((unsigned)(t1_ - 1) >> 31), mb1 = (float)((unsigned)(-t1_ - 1) >> 31);
          float w0 = mf0 * dfj[jj] * __expf(fminf(Lfi0 - lfj[jj], 0.f)) + mb0 * dbj[jj] * __expf(fminf(Lbi0 - lbj[jj], 0.f));
          float w1 = mf1 * dfj[jj] * __expf(fminf(Lfi1 - lfj[jj], 0.f)) + mb1 * dbj[jj] * __expf(fminf(Lbi1 - lbj[jj], 0.f));
          acc[jf][0][jj] *= w0;
          acc[jf][1][jj] *= w1;
        }
      }
      mb[kk][0] = pack8(acc[2 * kk][0], acc[2 * kk + 1][0]);
      mb[kk][1] = pack8(acc[2 * kk][1], acc[2 * kk + 1][1]);
      asm volatile("" : "+v"(mb[kk][0]), "+v"(mb[kk][1]));
      __builtin_amdgcn_sched_barrier(0);
    }
  }
  __syncthreads();
#pragma unroll
  for (int i = 0; i < 4; ++i) {
    int idx = tid + i * 256;
    int r = idx >> 4, ch = (idx & 15) * 8;
    *(u32x4*)(sXT + r * KLS + ch) = rx[i];
  }
#pragma unroll
  for (int i = 0; i < 8; ++i) {
    int idx = tid + i * 256;
    int r = idx >> 4, ch = (idx & 15) * 8;
    *(u32x4*)(sBT + r * KLS + ch) = rt[i];
  }
  __syncthreads();
  {
    f32x4 yacc[2][4];
#pragma unroll
    for (int f = 0; f < 2; ++f)
#pragma unroll
      for (int pf = 0; pf < 4; ++pf) yacc[f][pf] = (f32x4){0.f, 0.f, 0.f, 0.f};
#pragma unroll
    for (int kk = 0; kk < 4; ++kk) {
      h16x8 b0 = mb[kk][0];
      h16x8 b1 = mb[kk][1];
#pragma unroll
      for (int pf = 0; pf < 4; ++pf) {
        const h16* xr = sXT + (pf * 16 + lr) * KLS + quad * 4;
        h16x8 a = read_split(xr + (2 * kk) * 16, xr + (2 * kk + 1) * 16);
        yacc[0][pf] = mfma16(a, b0, yacc[0][pf]);
        yacc[1][pf] = mfma16(a, b1, yacc[1][pf]);
      }
      __builtin_amdgcn_sched_barrier(0);
    }
    float* ybuf = (float*)(P.ws + OFF_YBUF);
    const float Dh = P.in[I_SSMD][l * 8 + h];
#pragma unroll
    for (int f = 0; f < 2; ++f) {
      int i = wave * 32 + f * 16 + lr;
#pragma unroll
      for (int pf = 0; pf < 4; ++pf) {
        f32x4 v = yacc[f][pf];
#pragma unroll
        for (int jj = 0; jj < 4; ++jj) v[jj] += Dh * (float)sXT[(pf * 16 + quad * 4 + jj) * KLS + i];
        *(float4*)(ybuf + (size_t)(row0 + t0 + i) * 512 + h * 64 + pf * 16 + quad * 4) = make_float4(v[0], v[1], v[2], v[3]);
      }
    }
  }
#pragma unroll 1
  for (int dir = 0; dir < 2; ++dir) {
    const float* wx = dir ? wb : wf;
    int lr2 = lr;
    asm volatile("" : "+v"(lr2));
    f32x4 sacc[8];
#pragma unroll
    for (int nf = 0; nf < 8; ++nf) sacc[nf] = (f32x4){0.f, 0.f, 0.f, 0.f};
#pragma unroll
    for (int ks = 0; ks < 4; ++ks) {
      int j0 = ks * 32 + quad * 8;
      h16x8 x = *(const h16x8*)(sXT + (wave * 16 + lr2) * KLS + j0);
      f32x4 wa = *(const f32x4*)(wx + j0), wc = *(const f32x4*)(wx + j0 + 4);
      h16x8 xw;
#pragma unroll
      for (int e = 0; e < 4; ++e) {
        xw[e] = (h16)((float)x[e] * wa[e]);
        xw[e + 4] = (h16)((float)x[e + 4] * wc[e]);
      }
#pragma unroll
      for (int nf = 0; nf < 8; ++nf) {
        h16x8 a = *(const h16x8*)(sBT + (nf * 16 + lr2) * KLS + j0);
        sacc[nf] = mfma16(a, xw, sacc[nf]);
      }
    }
    h16* st = (h16*)(P.ws + OFF_STATES) + ((size_t)(bc * 8 + h) * 2 + dir) * 8192;
    int p = wave * 16 + lr;
#pragma unroll
    for (int nf = 0; nf < 8; ++nf) {
      int n = nf * 16 + quad * 4;
      *(h16x4*)(st + p * 128 + n) = pack4(sacc[nf]);
    }
  }
}

__device__ __forceinline__ void pool_unit(const Params& P, int l, int tile, int g, char* lds) {
  int rowt = tile * 64;
  bool lat = rowt >= MCTX;
  int T = lat ? 1024 : 256;
  int row0 = lat ? MCTX + (((rowt - MCTX) >> 10) << 10) : (rowt >> 8) << 8;
  int t0 = rowt - row0;
  int tid = threadIdx.x;
  asm volatile("" : "+v"(tid));
  int lane = tid & 63, wave = tid >> 6;
  int lr = lane & 15, quad = lane >> 4;
  h16* sP = (h16*)lds;
  h16* sA = sP + 80 * KLS;
  const h16* proj = (const h16*)(P.ws + OFF_PROJ);
  __syncthreads();
  for (int idx = tid; idx < 80 * 16; idx += NTHREADS) {
    int r = idx >> 4, c = (idx & 15) * 8;
    int tt = t0 - 8 + r;
    if (tt >= 0 && tt < T)
      *(uint4*)(sP + r * KLS + c) = *(const uint4*)(proj + (size_t)(row0 + tt) * DPROJ + C_PC + g * 128 + c);
  }
  __syncthreads();
  const int w = 2 << g;
  for (int idx = tid; idx < 64 * 16; idx += NTHREADS) {
    int tl = idx >> 4, c = (idx & 15) * 8;
    int t = t0 + tl;
    int lo = t - (w >> 1); if (lo < 0) lo = 0;
    int hi = t - (w >> 1) + w; if (hi > T) hi = T;
    float s[8];
#pragma unroll
    for (int e = 0; e < 8; ++e) s[e] = 0.f;
    for (int tt = lo; tt < hi; ++tt) {
      h16x8 x = *(const h16x8*)(sP + (tt - t0 + 8) * KLS + c);
#pragma unroll
      for (int e = 0; e < 8; ++e) s[e] += (float)x[e];
    }
    float invn = 1.f / (float)(hi - lo);
    h16x8 self = *(const h16x8*)(sP + (tl + 8) * KLS + c);
    h16x8 o;
#pragma unroll
    for (int e = 0; e < 8; ++e) o[e] = (h16)(s[e] * invn - (float)self[e]);
    *(h16x8*)(sA + tl * KLS + c) = o;
  }
  __syncthreads();
  const h16* WT = (const h16*)(P.ws + OFF_POOLWT) + (size_t)(l * 4 + g) * 128 * 128;
  f32x4 acc[8];
#pragma unroll
  for (int d = 0; d < 8; ++d) acc[d] = (f32x4){0.f, 0.f, 0.f, 0.f};
#pragma unroll
  for (int ks = 0; ks < 4; ++ks) {
    h16x8 bo = *(const h16x8*)(sA + (wave * 16 + lr) * KLS + ks * 32 + quad * 8);
#pragma unroll
    for (int d = 0; d < 8; ++d) {
      h16x8 a = *(const h16x8*)(WT + (d * 16 + lr) * 128 + ks * 32 + quad * 8);
      acc[d] = mfma16(a, bo, acc[d]);
    }
  }
  size_t row = (size_t)rowt + wave * 16 + lr;
  const float* pb = P.in[I_POOLB] + (l * 4 + g) * 128;
  const float* ps = P.in[I_POOLS] + l * 512 + g * 128;
  const h16* grow = proj + row * DPROJ + C_GC + g * 128;
  h16* orow = (h16*)(P.ws + OFF_U) + row * DM + 1024 + g * 128;
#pragma unroll
  for (int d = 0; d < 8; ++d) {
    int dd = d * 16 + quad * 4;
    float4 b4 = *(const float4*)(pb + dd), s4 = *(const float4*)(ps + dd);
    h16x4 gt = *(const h16x4*)(grow + dd);
    h16x4 o;
    o[0] = (h16)((acc[d][0] + b4.x) * s4.x * silu_f((float)gt[0]));
    o[1] = (h16)((acc[d][1] + b4.y) * s4.y * silu_f((float)gt[1]));
    o[2] = (h16)((acc[d][2] + b4.z) * s4.z * silu_f((float)gt[2]));
    o[3] = (h16)((acc[d][3] + b4.w) * s4.w * silu_f((float)gt[3]));
    *(h16x4*)(orow + dd) = o;
  }
}

__device__ __forceinline__ void mix1_phase(const Params& P, int l, char* lds) {
  const int U_LD = 256, U_LA = 256, U_SSL = 256, U_SSC = 512, U_CA = 512, U_CD = 512, U_POOL = 768;
  const int total = U_LD + U_LA + U_SSL + U_SSC + U_CA + U_CD + U_POOL;
  for (int u = blockIdx.x; u < total; u += gridDim.x) {
    int v = u;
    if (v < U_LD) { attn_unit(P, l, 3, v >> 6, (v >> 4) & 3, v & 15, lds); continue; }
    v -= U_LD;
    if (v < U_LA) { attn_unit(P, l, 2, v >> 6, (v >> 4) & 3, v & 15, lds); continue; }
    v -= U_LA;
    if (v < U_SSL) { ssd_intra_unit(P, l, true, v >> 6, (v >> 3) & 7, v & 7, lds); continue; }
    v -= U_SSL;
    if (v < U_SSC) { ssd_intra_unit(P, l, false, v >> 4, (v >> 3) & 1, v & 7, lds); continue; }
    v -= U_SSC;
    if (v < U_CA) { attn_unit(P, l, 0, v >> 4, (v >> 2) & 3, v & 3, lds); continue; }
    v -= U_CA;
    if (v < U_CD) { attn_unit(P, l, 1, v >> 4, (v >> 2) & 3, v & 3, lds); continue; }
    v -= U_CD;
    pool_unit(P, l, v >> 2, v & 3, lds);
  }
}

__device__ __forceinline__ h16x8 hstart_frag(const Params& P, int l, bool lat, int b, int c, int h, int dir, int p, int n) {
  if (!lat) {
    bool zero = (dir == 0) ? (c == 0) : (c == 1);
    h16x8 z = {0, 0, 0, 0, 0, 0, 0, 0};
    if (zero) return z;
    int bc = b * 2 + (dir == 0 ? 0 : 1);
    return *(const h16x8*)((const h16*)(P.ws + OFF_STATES) + ((size_t)(bc * 8 + h) * 2 + dir) * 8192 + p * 128 + n);
  }
  return *(const h16x8*)((const h16*)(P.ws + OFF_HS) + ((size_t)(((b * 8 + c) * 8 + h) * 2 + dir)) * 8192 + p * 128 + n);
}

#define CLS 264
#define XLS 520
__device__ __forceinline__ void ssd_inter_unit(const Params& P, int l, bool lat, int b, int c, int sub, char* lds) {
  const int T = lat ? 1024 : 256;
  const int row0 = lat ? MCTX + b * 1024 : b * 256;
  const int tc0 = c * 128;
  const int t0 = tc0 + sub * 32;
  int tid = threadIdx.x;
  asm volatile("" : "+v"(tid));
  int lane = tid & 63, wave = tid >> 6;
  int lr = lane & 15, quad = lane >> 4;
  h16* sC = (h16*)lds;
  h16* sX = sC + 32 * CLS;
  float* eL = (float*)(lds + 50176);
  float* sred = eL + 16 * 32;
  const h16* proj = (const h16*)(P.ws + OFF_PROJ);
  __syncthreads();
  const int bc = lat ? 64 + b * 8 + c : b * 2 + c;
  {
    const float* LL = (const float*)(P.ws + OFF_LL) + (size_t)bc * 16 * 128 + sub * 32;
#pragma unroll
    for (int i = 0; i < 2; ++i) {
      int idx = tid + i * 256;
      int combo = idx >> 5, r = idx & 31;
      eL[combo * 32 + r] = __expf(LL[combo * 128 + r]);
    }
    const h16* xbcn = (const h16*)(P.ws + OFF_XBCN) + (size_t)(row0 + t0) * 512 + 256;
#pragma unroll
    for (int i = 0; i < 4; ++i) {
      int idx = tid + i * 256;
      int r = idx >> 5, ch = (idx & 31) * 8;
      *(uint4*)(sC + r * CLS + ch) = *(const uint4*)(xbcn + (size_t)r * 512 + ch);
    }
  }
  __syncthreads();
  float ssq[2] = {0.f, 0.f};
  const float* ybuf = (const float*)(P.ws + OFF_YBUF);
#pragma unroll 1
  for (int hh = 0; hh < 2; ++hh) {
    const int h = wave * 2 + hh;
    const int g = h >> 2;
    float vals[4][2][4];
#pragma unroll
    for (int pf = 0; pf < 4; ++pf)
#pragma unroll
      for (int f = 0; f < 2; ++f)
#pragma unroll
        for (int jj = 0; jj < 4; ++jj) vals[pf][f][jj] = 0.f;
#pragma unroll 1
    for (int dir = 0; dir < 2; ++dir) {
      f32x4 acc[4][2];
#pragma unroll
      for (int pf = 0; pf < 4; ++pf) { acc[pf][0] = (f32x4){0.f, 0.f, 0.f, 0.f}; acc[pf][1] = (f32x4){0.f, 0.f, 0.f, 0.f}; }
#pragma unroll
      for (int ks = 0; ks < 4; ++ks) {
        h16x8 b0 = *(const h16x8*)(sC + (lr)*CLS + g * 128 + ks * 32 + quad * 8);
        h16x8 b1 = *(const h16x8*)(sC + (16 + lr) * CLS + g * 128 + ks * 32 + quad * 8);
#pragma unroll
        for (int pf = 0; pf < 4; ++pf) {
          h16x8 a = hstart_frag(P, l, lat, b, c, h, dir, pf * 16 + lr, ks * 32 + quad * 8);
          acc[pf][0] = mfma16(a, b0, acc[pf][0]);
          acc[pf][1] = mfma16(a, b1, acc[pf][1]);
        }
      }
      float e0 = eL[(h * 2 + dir) * 32 + lr], e1 = eL[(h * 2 + dir) * 32 + 16 + lr];
#pragma unroll
      for (int pf = 0; pf < 4; ++pf)
#pragma unroll
        for (int jj = 0; jj < 4; ++jj) {
          vals[pf][0][jj] += e0 * acc[pf][0][jj];
          vals[pf][1][jj] += e1 * acc[pf][1][jj];
        }
    }
#pragma unroll
    for (int f = 0; f < 2; ++f) {
      int il = f * 16 + lr;
      size_t row = (size_t)(row0 + t0 + il);
#pragma unroll
      for (int pf = 0; pf < 4; ++pf) {
        int ch = h * 64 + pf * 16 + quad * 4;
        float4 yi = *(const float4*)(ybuf + row * 512 + ch);
        h16x4 zv = *(const h16x4*)(proj + row * DPROJ + C_Z + ch);
        float y0 = vals[pf][f][0] + yi.x;
        float y1 = vals[pf][f][1] + yi.y;
        float y2 = vals[pf][f][2] + yi.z;
        float y3 = vals[pf][f][3] + yi.w;
        y0 *= silu_f((float)zv[0]); y1 *= silu_f((float)zv[1]); y2 *= silu_f((float)zv[2]); y3 *= silu_f((float)zv[3]);
        ssq[f] += y0 * y0 + y1 * y1 + y2 * y2 + y3 * y3;
        h16x4 o;
        o[0] = (h16)y0; o[1] = (h16)y1; o[2] = (h16)y2; o[3] = (h16)y3;
        *(h16x4*)(sX + il * XLS + ch) = o;
      }
    }
  }
#pragma unroll
  for (int f = 0; f < 2; ++f) {
    ssq[f] += __shfl_xor(ssq[f], 16);
    ssq[f] += __shfl_xor(ssq[f], 32);
    if (quad == 0) sred[wave * 32 + f * 16 + lr] = ssq[f];
  }
  __syncthreads();
  const float* nw = P.in[I_NORMW] + l * 512;
  h16* mixed = (h16*)(P.ws + OFF_U);
#pragma unroll
  for (int f = 0; f < 2; ++f) {
    int il = f * 16 + lr;
    float tot = sred[il] + sred[32 + il] + sred[64 + il] + sred[96 + il];
    float rstd = rsqrtf(tot * (1.f / 512.f) + 1e-6f);
    size_t row = (size_t)(row0 + t0 + il);
#pragma unroll 1
    for (int hh = 0; hh < 2; ++hh) {
      int h = wave * 2 + hh;
#pragma unroll
      for (int pf = 0; pf < 4; ++pf) {
        int ch = h * 64 + pf * 16 + quad * 4;
        float4 w4 = *(const float4*)(nw + ch);
        h16x4 yv = *(const h16x4*)(sX + il * XLS + ch);
        h16x4 o;
        o[0] = (h16)((float)yv[0] * rstd * w4.x);
        o[1] = (h16)((float)yv[1] * rstd * w4.y);
        o[2] = (h16)((float)yv[2] * rstd * w4.z);
        o[3] = (h16)((float)yv[3] * rstd * w4.w);
        *(h16x4*)(mixed + row * DM + 512 + ch) = o;
      }
    }
  }
}

__device__ __forceinline__ void scan_phase(const Params& P, int l) {
  const int U_LAT = 512, U_FIN = 512;
  const float* h0f_ = P.in[I_SF];
  const float* h0b_ = P.in[I_SB];
  asm volatile("" : "+v"(h0f_), "+v"(h0b_));
  int tid = threadIdx.x;
  asm volatile("" : "+v"(tid));
  const h16* st = (const h16*)(P.ws + OFF_STATES);
  const float* cd = (const float*)(P.ws + OFF_CDEC);
  for (int u = blockIdx.x; u < U_LAT + U_FIN; u += gridDim.x) {
    if (u < U_LAT) {
      int sl = u & 7, dir = (u >> 3) & 1, h = (u >> 4) & 7, b = u >> 7;
      int idx = sl * 1024 + tid * 4;
      float4 hv = *(const float4*)((dir == 0 ? h0f_ : h0b_) + ((size_t)((b * 2 + l) * 8 + h)) * 8192 + idx);
      h16x4 sv[8];
      float dc[8];
#pragma unroll
      for (int s_ = 0; s_ < 8; ++s_) {
        int cc = (dir == 0) ? s_ : 7 - s_;
        int bc = 64 + b * 8 + cc;
        sv[s_] = *(const h16x4*)(st + ((size_t)(bc * 8 + h) * 2 + dir) * 8192 + idx);
        dc[s_] = cd[(bc * 8 + h) * 2 + dir];
      }
      h16* hs = (h16*)(P.ws + OFF_HS);
#pragma unroll
      for (int s_ = 0; s_ < 8; ++s_) {
        int cc = (dir == 0) ? s_ : 7 - s_;
        h16x4 o;
        o[0] = (h16)hv.x; o[1] = (h16)hv.y; o[2] = (h16)hv.z; o[3] = (h16)hv.w;
        *(h16x4*)(hs + ((size_t)(((b * 8 + cc) * 8 + h) * 2 + dir)) * 8192 + idx) = o;
        hv.x = dc[s_] * hv.x + (float)sv[s_][0]; hv.y = dc[s_] * hv.y + (float)sv[s_][1];
        hv.z = dc[s_] * hv.z + (float)sv[s_][2]; hv.w = dc[s_] * hv.w + (float)sv[s_][3];
      }
    } else {
      int v = u - U_LAT;
      int dir = v & 1, h = (v >> 1) & 7, b = v >> 4;
      int cfirst = dir == 0 ? 0 : 1, clast = dir == 0 ? 1 : 0;
      int bcf = b * 2 + cfirst, bcl = b * 2 + clast;
      float dcy = cd[(bcl * 8 + h) * 2 + dir];
      const h16* s0 = st + ((size_t)(bcf * 8 + h) * 2 + dir) * 8192;
      const h16* s1 = st + ((size_t)(bcl * 8 + h) * 2 + dir) * 8192;
      float* o = P.out + (dir == 0 ? O_SF : O_SB) + ((size_t)((b * 2 + l) * 8 + h)) * 8192;
#pragma unroll
      for (int i = 0; i < 8; ++i) {
        int idx = (i * 256 + tid) * 4;
        h16x4 a = *(const h16x4*)(s0 + idx), c4 = *(const h16x4*)(s1 + idx);
        *(float4*)(o + idx) = make_float4(dcy * (float)a[0] + (float)c4[0], dcy * (float)a[1] + (float)c4[1],
                                          dcy * (float)a[2] + (float)c4[2], dcy * (float)a[3] + (float)c4[3]);
      }
    }
  }
}

__device__ __forceinline__ void mix2_phase(const Params& P, int l, char* lds) {
  const int U_LAT = 128, U_CTX = 256;
  for (int u = blockIdx.x; u < U_LAT + U_CTX; u += gridDim.x) {
    int v = u;
    if (v < U_LAT) { ssd_inter_unit(P, l, true, v >> 5, (v >> 2) & 7, v & 3, lds); continue; }
    v -= U_LAT;
    ssd_inter_unit(P, l, false, v >> 3, (v >> 2) & 1, v & 3, lds);
  }
}

#define XB_TMO      128
#define XB_XCNT(j)  (256  + 64 * (j))
#define XB_XSUB(j)  (1280 + 64 * (j))
#define XB_XGEN(j)  (2304 + 64 * (j))
#define XB_TOP      3328
#define XB_TOPGEN   3392
#define XCD_BAR_WORDS 3456
#define XB_SPIN_CAP (1u << 18)
#define LAS __attribute__((address_space(3)))
__device__ __forceinline__ unsigned xb_ld(unsigned* p)              { return __hip_atomic_load(p, __ATOMIC_RELAXED, __HIP_MEMORY_SCOPE_AGENT); }
__device__ __forceinline__ unsigned xb_add(unsigned* p, unsigned v) { return __hip_atomic_fetch_add(p, v, __ATOMIC_RELAXED, __HIP_MEMORY_SCOPE_AGENT); }
__device__ __forceinline__ unsigned xb_xcc_id() { return (unsigned)__builtin_amdgcn_s_getreg((3 << 11) | 20) & 0xFu; }
#define XB_SPIN(cond, bar) do { unsigned _sp = 0; while (cond) { __builtin_amdgcn_s_sleep(1); \
    if ((++_sp & 255u) == 0u) { if (xb_ld(&(bar)[XB_TMO])) break; if (_sp > XB_SPIN_CAP) { atomicAdd(&(bar)[XB_TMO], 1u); break; } } } } while (0)
struct XcdBarrier { unsigned* bar; unsigned x; volatile LAS unsigned* st; };
__device__ __forceinline__ XcdBarrier xcd_barrier_post(unsigned* bar, volatile LAS unsigned* st) {
    XcdBarrier b; b.bar = bar; b.x = xb_xcc_id(); b.st = st;
    if (threadIdx.x == 0) (void)xb_add(&bar[XB_XCNT(b.x)], 1u);
    return b;
}
__device__ __forceinline__ void xcd_barrier_complete(unsigned* bar, unsigned x, unsigned& nloc, unsigned& nx) {
    const unsigned G = gridDim.x * gridDim.y * gridDim.z;
    unsigned sum, cnt, mine, sp = 0u;
    for (;;) {
        sum = 0u; cnt = 0u; mine = 0u;
#pragma unroll
        for (unsigned j = 0; j < 16; ++j) { const unsigned c = xb_ld(&bar[XB_XCNT(j)]); sum += c; cnt += (c > 0u) ? 1u : 0u; mine = (j == x) ? c : mine; }
        if (sum == G) break;
        __builtin_amdgcn_s_sleep(1);
        if ((++sp & 255u) == 0u) { if (xb_ld(&bar[XB_TMO])) break; if (sp > XB_SPIN_CAP) { atomicAdd(&bar[XB_TMO], 1u); break; } }
    }
    nloc = mine > 0u ? mine : 1u; nx = cnt > 0u ? cnt : 1u;
}
__device__ __forceinline__ void xcd_barrier(const XcdBarrier& b) {
    asm volatile("s_waitcnt vmcnt(0)" ::: "memory");
    __syncthreads();
    if (threadIdx.x == 0) {
        unsigned* bar = b.bar;
        asm volatile("" : "+v"(bar));
        __builtin_amdgcn_s_waitcnt(0);
        unsigned nloc = b.st[0], nx = b.st[1];
        if (nloc == 0u) { xcd_barrier_complete(bar, b.x, nloc, nx); b.st[0] = nloc; b.st[1] = nx; }
        const unsigned old = xb_add(&bar[XB_XSUB(b.x)], 1u);
        const unsigned gen = old / nloc;
        if (old + 1u == (gen + 1u) * nloc) {
            __builtin_amdgcn_fence(__ATOMIC_RELEASE, "agent");
            asm volatile("s_waitcnt vmcnt(0)" ::: "memory");
            const unsigned og = xb_add(&bar[XB_TOP], 1u);
            const unsigned tg = og / nx;
            if (og + 1u == (tg + 1u) * nx) xb_add(&bar[XB_TOPGEN], 1u);
            else XB_SPIN(xb_ld(&bar[XB_TOPGEN]) == tg, bar);
            __builtin_amdgcn_fence(__ATOMIC_ACQUIRE, "agent");
            xb_add(&bar[XB_XGEN(b.x)], 1u);
            asm volatile("s_waitcnt vmcnt(0)" ::: "memory");
        } else {
            XB_SPIN(xb_ld(&bar[XB_XGEN(b.x)]) == gen, bar);
            __builtin_amdgcn_fence(__ATOMIC_ACQUIRE, "agent");
            asm volatile("s_waitcnt vmcnt(0)" ::: "memory");
        }
    }
    __syncthreads();
}

__global__ void __launch_bounds__(NTHREADS, 2) mega_kernel(Params P) {
  __shared__ __attribute__((aligned(16))) char lds[LDS_BYTES];
  __shared__ uint4 xb_words;
  cg::grid_group grid = cg::this_grid();
  if (P.phase_lo < 0) grid.sync();
  if (threadIdx.x == 0) xb_words = make_uint4(0u, 0u, 0u, 0u);
  __syncthreads();
  XcdBarrier xb = xcd_barrier_post((unsigned*)(P.ws + OFF_BAR), (volatile LAS unsigned*)&xb_words);
  for (int ph = P.phase_lo; ph < P.phase_hi; ++ph) {
    const int l = (ph == 0) ? 0 : (ph - 1) / 7;
    const int k = (ph == 0) ? -1 : (ph == 15 ? 0 : (ph - 1) % 7);
    switch (k) {
      case -1: prep_phase(P, lds); break;
      case 0: if (ph == 1) prep_rest_phase(P, lds); row_phase(P, l); break;
      case 1: gemm_in_phase(P, l, lds); break;
      case 2: conv_phase(P, l, lds); break;
      case 3: mix1_phase(P, l, lds); break;
      case 4: scan_phase(P, l); break;
      case 5: mix2_phase(P, l, lds); break;
      default: gemm_phase<1>(P, l, lds); break;
    }
    if (ph + 1 < P.phase_hi) xcd_barrier(xb);
  }
}

#ifndef MK_MULTI
#define MK_MULTI 0
#endif

extern "C" void kernel_launch(void* const* d_in, const int* in_sizes, int n_in, void* d_out, int out_size, void* d_ws,
                              size_t ws_size, hipStream_t stream) {
  if (ws_size < WS_NEED) {
    fprintf(stderr, "workspace too small: %zu < %zu\n", ws_size, (size_t)WS_NEED);
    return;
  }
  static int grid_blocks = 0;
  if (!grid_blocks) {
    int dev = 0, cus = 0, per_cu = 0;
    hipGetDevice(&dev);
    hipDeviceGetAttribute(&cus, hipDeviceAttributeMultiprocessorCount, dev);
    hipOccupancyMaxActiveBlocksPerMultiprocessor(&per_cu, mega_kernel, NTHREADS, 0);
    if (per_cu > 2) per_cu = 2;
    if (per_cu < 1) per_cu = 1;
    grid_blocks = cus * per_cu;
  }
  Params p{};
  for (int i = 0; i < 27; ++i) p.in[i] = (const float*)d_in[i];
  p.out = (float*)d_out;
  p.ws = (char*)d_ws;
  hipMemsetAsync((char*)d_ws + OFF_MOD, 0, SZ_MOD + SZ_BAR, stream);
#if MK_MULTI
  for (int ph = 0; ph < 16; ++ph) {
    p.phase_lo = ph; p.phase_hi = ph + 1;
    hipLaunchKernelGGL(mega_kernel, dim3(grid_blocks), dim3(NTHREADS), 0, stream, p);
  }
#else
  p.phase_lo = 0; p.phase_hi = 16;
  void* args[] = {&p};
  hipError_t e = hipLaunchCooperativeKernel((void*)mega_kernel, dim3(grid_blocks), dim3(NTHREADS), args, 0, stream);
  if (e != hipSuccess) fprintf(stderr, "cooperative launch failed: %s (grid %d)\n", hipGetErrorString(e), grid_blocks);
#endif
}
```

```cpp
#include <hip/hip_runtime.h>
#include <hip/hip_fp16.h>
#include <hip/hip_cooperative_groups.h>
#include <cstdio>
namespace cg = cooperative_groups;

typedef _Float16 h16;
typedef __attribute__((ext_vector_type(8))) _Float16 h16x8;
typedef __attribute__((ext_vector_type(4))) _Float16 h16x4;
typedef __attribute__((ext_vector_type(4))) float f32x4;

#define DM 2048
#define MTOK 12288
#define MCTX 8192
#define DPROJ 6160
#define NPAD 6272
#define NTHREADS 256

#define C_QA 0
#define C_KA 512
#define C_VA 768
#define C_GA 1024
#define C_XBC 1536
#define C_Z 2560
#define C_DT 3072
#define C_PC 3088
#define C_GC 3600
#define C_QD 4112
#define C_KD 4624
#define C_VD 5136
#define C_GD 5648

#define O_Y 0
#define O_NAK 25165824
#define O_NAV 29360128
#define O_NNK 33554432
#define O_NNV 41943040
#define O_SF 50331648
#define O_SB 54525952

constexpr size_t SZ_WTIN = 2ull * NPAD * DM * 2;
constexpr size_t SZ_WTOUT = 2ull * DM * DM * 2;
constexpr size_t SZ_POOLWT = 2ull * 4 * 128 * 128 * 2;
constexpr size_t SZ_MOD = 2ull * 5 * 6144 * 4;
constexpr size_t SZ_BAR = 14080;
constexpr size_t SZ_ROPE = 1024ull * 64 * 8;
constexpr size_t SZ_KCA = 4ull * 2 * 256 * 256 * 2;
constexpr size_t SZ_KCD = 4ull * 2 * 256 * 512 * 2;
constexpr size_t SZ_VTAC = SZ_KCA;
constexpr size_t SZ_VTDC = SZ_KCD;
constexpr size_t SZ_U = (size_t)MTOK * DM * 2;
constexpr size_t SZ_PROJ = (size_t)MTOK * DPROJ * 2;
constexpr size_t SZ_VTA_CTX = 32ull * 2 * 128 * 256 * 2;
constexpr size_t SZ_VTA_LAT = 4ull * 2 * 128 * 1024 * 2;
constexpr size_t SZ_VTD_CTX = 32ull * 4 * 128 * 256 * 2;
constexpr size_t SZ_VTD_LAT = 4ull * 4 * 128 * 1024 * 2;
constexpr size_t SZ_YBUF = (size_t)MTOK * 512 * 4;
constexpr size_t SZ_STATES = 96ull * 8 * 2 * 8192 * 2;
constexpr size_t SZ_CDEC = 96ull * 8 * 2 * 4;
constexpr size_t SZ_HS = 4ull * 8 * 8 * 2 * 8192 * 2;

constexpr size_t OFF_WTIN = 0;
constexpr size_t OFF_WTOUT = OFF_WTIN + SZ_WTIN;
constexpr size_t OFF_POOLWT = OFF_WTOUT + SZ_WTOUT;
constexpr size_t OFF_MOD = OFF_POOLWT + SZ_POOLWT;
constexpr size_t OFF_BAR = OFF_MOD + SZ_MOD;
constexpr size_t OFF_ROPE = OFF_BAR + SZ_BAR;
constexpr size_t OFF_KCA = OFF_ROPE + SZ_ROPE;
constexpr size_t OFF_KCD = OFF_KCA + SZ_KCA;
constexpr size_t OFF_VTAC = OFF_KCD + SZ_KCD;
constexpr size_t OFF_VTDC = OFF_VTAC + SZ_VTAC;
constexpr size_t OFF_U = OFF_VTDC + SZ_VTDC;
constexpr size_t OFF_PROJ = OFF_U + SZ_U;
constexpr size_t OFF_VTA_CTX = OFF_PROJ + SZ_PROJ;
constexpr size_t OFF_VTA_LAT = OFF_VTA_CTX + SZ_VTA_CTX;
constexpr size_t OFF_VTD_CTX = OFF_VTA_LAT + SZ_VTA_LAT;
constexpr size_t OFF_VTD_LAT = OFF_VTD_CTX + SZ_VTD_CTX;
constexpr size_t OFF_YBUF = OFF_VTD_LAT + SZ_VTD_LAT;
constexpr size_t OFF_STATES = OFF_YBUF + SZ_YBUF;
constexpr size_t OFF_CDEC = OFF_STATES + SZ_STATES;
constexpr size_t OFF_HS = OFF_CDEC + SZ_CDEC + 256;
constexpr size_t SZ_XBCN = (size_t)MTOK * 512 * 2;
constexpr size_t SZ_XT = (size_t)MTOK * 512 * 2;
constexpr size_t SZ_BT = (size_t)MTOK * 256 * 2;
constexpr size_t SZ_DTL = 96ull * 16 * 128 * 4;
constexpr size_t OFF_XBCN = OFF_HS + SZ_HS;
constexpr size_t OFF_XT = OFF_XBCN + SZ_XBCN;
constexpr size_t OFF_BT = OFF_XT + SZ_XT;
constexpr size_t OFF_DT = OFF_BT + SZ_BT;
constexpr size_t OFF_LL = OFF_DT + SZ_DTL;
constexpr size_t WS_NEED = OFF_LL + SZ_DTL + 256;

struct Params {
  const float* in[27];
  float* out;
  char* ws;
  int phase_lo, phase_hi;
};

enum { I_XP = 0, I_XS, I_CAK, I_CAV, I_CNK, I_CNV, I_SF, I_SB, I_C, I_CCTX, I_WADA, I_BADA, I_WIN, I_WOUT,
       I_LNG, I_LNB, I_SINK, I_CONVW, I_CONVB, I_ALOG, I_DTB, I_SSMD, I_NORMW, I_POOLW, I_POOLB, I_POOLS, I_RPB };

#define LDS_BYTES 73728

__device__ __forceinline__ float silu_f(float x) { return x / (1.f + __expf(-x)); }
__device__ __forceinline__ f32x4 mfma16(h16x8 a, h16x8 b, f32x4 c) {
  return __builtin_amdgcn_mfma_f32_16x16x32_f16(a, b, c, 0, 0, 0);
}
__device__ __forceinline__ h16x8 pack8(f32x4 a, f32x4 b) {
  h16x8 r;
  r[0] = (h16)a[0]; r[1] = (h16)a[1]; r[2] = (h16)a[2]; r[3] = (h16)a[3];
  r[4] = (h16)b[0]; r[5] = (h16)b[1]; r[6] = (h16)b[2]; r[7] = (h16)b[3];
  return r;
}
__device__ __forceinline__ h16x4 pack4(f32x4 a) {
  h16x4 r;
  r[0] = (h16)a[0]; r[1] = (h16)a[1]; r[2] = (h16)a[2]; r[3] = (h16)a[3];
  return r;
}
__device__ __forceinline__ h16x8 read_split(const h16* p0, const h16* p1) {
  h16x4 a = *(const h16x4*)p0;
  h16x4 b = *(const h16x4*)p1;
  return __builtin_shufflevector(a, b, 0, 1, 2, 3, 4, 5, 6, 7);
}
__device__ __forceinline__ void st_nt4(float* p, float a, float b, float c, float d) {
  f32x4 v = {a, b, c, d};
  __builtin_nontemporal_store(v, (f32x4*)p);
}
__device__ __forceinline__ float wave_sum(float v) {
#pragma unroll
  for (int o = 32; o > 0; o >>= 1) v += __shfl_xor(v, o);
  return v;
}
__device__ __forceinline__ int row_cond(int row) { return row < MCTX ? 0 : 1 + ((row - MCTX) >> 10); }

__device__ __forceinline__ void transpose_tile(const float* __restrict__ src, int sstride, int cvalid, h16* __restrict__ dst,
                               int dstride, int r0, int c0, char* lds) {
  float* tile = (float*)lds;
  int tid = threadIdx.x;
  asm volatile("" : "+v"(tid));
  int c = tid & 63, rr = tid >> 6;
#pragma unroll
  for (int i = 0; i < 16; ++i) {
    int r = i * 4 + rr;
    float v = 0.f;
    if (c0 + c < cvalid) v = src[(size_t)(r0 + r) * sstride + c0 + c];
    tile[r * 65 + c] = v;
  }
  __syncthreads();
  int cc = tid >> 2, rq = (tid & 3) * 16;
  h16x8 o0, o1;
#pragma unroll
  for (int k = 0; k < 8; ++k) {
    o0[k] = (h16)tile[(rq + k) * 65 + cc];
    o1[k] = (h16)tile[(rq + 8 + k) * 65 + cc];
  }
  h16* d = dst + (size_t)(c0 + cc) * dstride + r0 + rq;
  *(h16x8*)d = o0;
  *(h16x8*)(d + 8) = o1;
  __syncthreads();
}

__device__ __forceinline__ void transpose_wide(const float* __restrict__ src, int sstride, int cvalid, h16* __restrict__ dst,
                                               int dstride, int nrows_dst, int r0, int c0, char* lds) {
  float* tile = (float*)lds;
  int tid = threadIdx.x;
  asm volatile("" : "+v"(tid));
  const int lane = tid & 63, rr = tid >> 6;
  const int c4 = lane * 4;
  float4 v[16];
#pragma unroll
  for (int i = 0; i < 16; ++i) {
    int r = rr + 4 * i;
    v[i] = make_float4(0.f, 0.f, 0.f, 0.f);
    if (c0 + c4 < cvalid) v[i] = *(const float4*)(src + (size_t)(r0 + r) * sstride + c0 + c4);
  }
#pragma unroll
  for (int i = 0; i < 16; ++i) *(float4*)(tile + (rr + 4 * i) * 260 + c4) = v[i];
  __syncthreads();
  if (c0 + tid < nrows_dst) {
    h16* d = dst + (size_t)(c0 + tid) * dstride + r0;
#pragma unroll
    for (int q = 0; q < 8; ++q) {
      h16x8 o;
#pragma unroll
      for (int e = 0; e < 8; ++e) o[e] = (h16)tile[(q * 8 + e) * 260 + tid];
      *(h16x8*)(d + q * 8) = o;
    }
  }
  __syncthreads();
}

__device__ __forceinline__ void ada_unit(const Params& P, int u, char* lds) {
  int kc = u & 15;
  int cgp = (u >> 4) % 24;
  int l = u / 384;
  int tid = threadIdx.x;
  asm volatile("" : "+v"(tid));
  int lane = tid & 63, wave = tid >> 6;
  const float* W = P.in[I_WADA] + (size_t)l * DM * 6144;
  int col = cgp * 256 + lane * 4;
  int k0 = kc * 128 + wave * 32;
  float acc[5][4];
#pragma unroll
  for (int c = 0; c < 5; ++c)
#pragma unroll
    for (int e = 0; e < 4; ++e) acc[c][e] = 0.f;
  const float* cctx = P.in[I_CCTX];
  const float* cl = P.in[I_C];
#pragma unroll 8
  for (int k = k0; k < k0 + 32; ++k) {
    float4 w = *(const float4*)(W + (size_t)k * 6144 + col);
    float s[5];
    s[0] = silu_f(cctx[k]);
#pragma unroll
    for (int c = 0; c < 4; ++c) s[c + 1] = silu_f(cl[c * DM + k]);
#pragma unroll
    for (int c = 0; c < 5; ++c) {
      acc[c][0] += s[c] * w.x; acc[c][1] += s[c] * w.y; acc[c][2] += s[c] * w.z; acc[c][3] += s[c] * w.w;
    }
  }
  float* red = (float*)lds;
#pragma unroll
  for (int c = 0; c < 5; ++c)
#pragma unroll
    for (int e = 0; e < 4; ++e) red[(wave * 5 + c) * 256 + lane * 4 + e] = acc[c][e];
  __syncthreads();
  float* mod = (float*)(P.ws + OFF_MOD) + (size_t)l * 5 * 6144;
  int ocol = cgp * 256 + tid;
  float bias = (kc == 0) ? P.in[I_BADA][l * 6144 + ocol] : 0.f;
#pragma unroll
  for (int c = 0; c < 5; ++c) {
    float s = red[(0 * 5 + c) * 256 + tid] + red[(1 * 5 + c) * 256 + tid] + red[(2 * 5 + c) * 256 + tid] +
              red[(3 * 5 + c) * 256 + tid];
    atomicAdd(mod + c * 6144 + ocol, s + bias);
  }
  __syncthreads();
}

__device__ __forceinline__ void prep_unit(const Params& P, int v, char* lds) {
  const int U_ADA = 768, U_WIN = 2 * 32 * 25, U_WOUT = 2 * 32 * 8, U_POOL = 32, U_VTA = 128, U_VTD = 256,
            U_KCA = 128, U_KCD = 256;
  int tid = threadIdx.x;
  asm volatile("" : "+v"(tid));
  {
    if (v < U_ADA) { ada_unit(P, v, lds); return; }
    v -= U_ADA;
    if (v < U_WIN) {
      int l = v / (32 * 25), r = v % (32 * 25);
      int kt = r / 25, ng = r % 25;
      transpose_wide(P.in[I_WIN] + (size_t)l * DM * DPROJ, DPROJ, DPROJ, (h16*)(P.ws + OFF_WTIN) + (size_t)l * NPAD * DM, DM,
                     NPAD, kt * 64, ng * 256, lds);
      return;
    }
    v -= U_WIN;
    if (v < U_WOUT) {
      int l = v / 256, r = v % 256;
      int kt = r / 8, ng = r % 8;
      transpose_wide(P.in[I_WOUT] + (size_t)l * DM * DM, DM, DM, (h16*)(P.ws + OFF_WTOUT) + (size_t)l * DM * DM, DM, DM,
                     kt * 64, ng * 256, lds);
      return;
    }
    v -= U_WOUT;
    if (v < U_POOL) {
      int lg = v >> 2, r = v & 3;
      transpose_tile(P.in[I_POOLW] + (size_t)lg * 128 * 128, 128, 128, (h16*)(P.ws + OFF_POOLWT) + (size_t)lg * 128 * 128,
                     128, (r >> 1) * 64, (r & 1) * 64, lds);
      return;
    }
    v -= U_POOL;
    if (v < U_VTA) {
      int bl = v >> 4, r = v & 15;
      transpose_tile(P.in[I_CAV] + (size_t)bl * 256 * 256, 256, 256, (h16*)(P.ws + OFF_VTAC) + (size_t)bl * 256 * 256, 256,
                     (r >> 2) * 64, (r & 3) * 64, lds);
      return;
    }
    v -= U_VTA;
    if (v < U_VTD) {
      int bl = v >> 5, r = v & 31;
      transpose_tile(P.in[I_CNV] + (size_t)bl * 256 * 512, 512, 512, (h16*)(P.ws + OFF_VTDC) + (size_t)bl * 512 * 256, 256,
                     (r >> 3) * 64, (r & 7) * 64, lds);
      return;
    }
    v -= U_VTD;
    if (v < U_KCA + U_KCD) {
      const float* src;
      h16* dst;
      if (v < U_KCA) { src = P.in[I_CAK]; dst = (h16*)(P.ws + OFF_KCA); }
      else { v -= U_KCA; src = P.in[I_CNK]; dst = (h16*)(P.ws + OFF_KCD); }
      size_t base = (size_t)v * 4096;
#pragma unroll
      for (int i = 0; i < 4; ++i) {
        size_t idx = base + (size_t)(i * 256 + tid) * 4;
        float4 x = *(const float4*)(src + idx);
        h16x4 o;
        o[0] = (h16)x.x; o[1] = (h16)x.y; o[2] = (h16)x.z; o[3] = (h16)x.w;
        *(h16x4*)(dst + idx) = o;
      }
      return;
    }
    v -= U_KCA + U_KCD;
    {
      float2* rope = (float2*)(P.ws + OFF_ROPE);
#pragma unroll
      for (int e = 0; e < 4; ++e) {
        int idx = v * 1024 + e * 256 + tid;
        int t = idx >> 6, j = idx & 63;
        int half = j >> 5, f = j & 31;
        float inv = powf(10000.f, -(float)f / 32.f);
        float pos = half ? (float)(t & 63) : (float)(t >> 6);
        float ang = pos * inv;
        rope[idx] = make_float2(cosf(ang), sinf(ang));
      }
    }
  }
}
__device__ __forceinline__ void prep_phase(const Params& P, char* lds) {
  for (int i = blockIdx.x; i < 384; i += gridDim.x) prep_unit(P, i, lds);
}
#define PREP_REST (384 + 1600 + 512 + 32 + 128 + 256 + 128 + 256 + 64)
__device__ __forceinline__ void prep_rest_phase(const Params& P, char* lds) {
  for (int i = blockIdx.x; i < PREP_REST; i += gridDim.x) prep_unit(P, 384 + i, lds);
}

__device__ __forceinline__ void row_phase(const Params& P, int l) {
  constexpr int RPW = 3;
  int tid = threadIdx.x;
  asm volatile("" : "+v"(tid));
  int lane = tid & 63, wave = tid >> 6;
  float* y = P.out + O_Y;
  h16* U = (h16*)(P.ws + OFF_U);
  const int nwaves = gridDim.x * 4;
  for (int grp = blockIdx.x * 4 + wave; grp * RPW < MTOK; grp += nwaves) {
    float4 x[RPW][8];
#pragma unroll
    for (int r = 0; r < RPW; ++r) {
      int row = grp * RPW + r;
      const float* src;
      if (l == 0) src = (row < MCTX) ? P.in[I_XP] + (size_t)row * DM : P.in[I_XS] + (size_t)(row - MCTX) * DM;
      else src = y + (size_t)row * DM;
#pragma unroll
      for (int i = 0; i < 8; ++i) x[r][i] = *(const float4*)(src + (i * 64 + lane) * 4);
    }
    if (l > 0) {
      const float* g = P.in[I_LNG] + (l - 1) * DM;
      const float* bb = P.in[I_LNB] + (l - 1) * DM;
#pragma unroll
      for (int r = 0; r < RPW; ++r) {
        int row = grp * RPW + r;
        float s = 0.f;
#pragma unroll
        for (int i = 0; i < 8; ++i) s += x[r][i].x + x[r][i].y + x[r][i].z + x[r][i].w;
        float mu = wave_sum(s) * (1.f / DM);
        float q = 0.f;
#pragma unroll
        for (int i = 0; i < 8; ++i) {
          float a = x[r][i].x - mu, b = x[r][i].y - mu, c = x[r][i].z - mu, d = x[r][i].w - mu;
          q += a * a + b * b + c * c + d * d;
        }
        float rstd = rsqrtf(wave_sum(q) * (1.f / DM) + 1e-6f);
#pragma unroll
        for (int i = 0; i < 8; ++i) {
          int c0 = (i * 64 + lane) * 4;
          float4 gg = *(const float4*)(g + c0), b4 = *(const float4*)(bb + c0);
          x[r][i].x = (x[r][i].x - mu) * rstd * gg.x + b4.x;
          x[r][i].y = (x[r][i].y - mu) * rstd * gg.y + b4.y;
          x[r][i].z = (x[r][i].z - mu) * rstd * gg.z + b4.z;
          x[r][i].w = (x[r][i].w - mu) * rstd * gg.w + b4.w;
          if (l == 2) st_nt4(y + (size_t)row * DM + c0, x[r][i].x, x[r][i].y, x[r][i].z, x[r][i].w);
          else *(float4*)(y + (size_t)row * DM + c0) = x[r][i];
        }
      }
    }
    if (l < 2) {
#pragma unroll
      for (int r = 0; r < RPW; ++r) {
        int row = grp * RPW + r;
        float s = 0.f;
#pragma unroll
        for (int i = 0; i < 8; ++i) s += x[r][i].x + x[r][i].y + x[r][i].z + x[r][i].w;
        float mu = wave_sum(s) * (1.f / DM);
        float q = 0.f;
#pragma unroll
        for (int i = 0; i < 8; ++i) {
          float a = x[r][i].x - mu, b = x[r][i].y - mu, c = x[r][i].z - mu, d = x[r][i].w - mu;
          q += a * a + b * b + c * c + d * d;
        }
        float rstd = rsqrtf(wave_sum(q) * (1.f / DM) + 1e-6f);
        const float* mod = (const float*)(P.ws + OFF_MOD) + ((size_t)l * 5 + row_cond(row)) * 6144;
#pragma unroll
        for (int i = 0; i < 8; ++i) {
          int c0 = (i * 64 + lane) * 4;
          float4 sh = *(const float4*)(mod + c0), sc = *(const float4*)(mod + 2048 + c0);
          h16x4 o;
          o[0] = (h16)((x[r][i].x - mu) * rstd * (1.f + sc.x) + sh.x);
          o[1] = (h16)((x[r][i].y - mu) * rstd * (1.f + sc.y) + sh.y);
          o[2] = (h16)((x[r][i].z - mu) * rstd * (1.f + sc.z) + sh.z);
          o[3] = (h16)((x[r][i].w - mu) * rstd * (1.f + sc.w) + sh.w);
          *(h16x4*)(U + (size_t)row * DM + c0) = o;
        }
      }
    }
  }
}

#define GLS 64
typedef __attribute__((ext_vector_type(4))) unsigned u32x4;
struct GStage { u32x4 w0, w1, w2, w3, u0, u1, u2, u3; };
__device__ __forceinline__ void g_load(GStage& S, const h16* gW, const h16* gU, int kt) {
  S.w0 = *(const u32x4*)(gW + (size_t)0 * 32 * DM + kt * 64);
  S.w1 = *(const u32x4*)(gW + (size_t)1 * 32 * DM + kt * 64);
  S.w2 = *(const u32x4*)(gW + (size_t)2 * 32 * DM + kt * 64);
  S.w3 = *(const u32x4*)(gW + (size_t)3 * 32 * DM + kt * 64);
  S.u0 = *(const u32x4*)(gU + (size_t)0 * 32 * DM + kt * 64);
  S.u1 = *(const u32x4*)(gU + (size_t)1 * 32 * DM + kt * 64);
  S.u2 = *(const u32x4*)(gU + (size_t)2 * 32 * DM + kt * 64);
  S.u3 = *(const u32x4*)(gU + (size_t)3 * 32 * DM + kt * 64);
}
__device__ __forceinline__ void g_store(const GStage& S, h16* sW, h16* sU, int buf, int ld_row, int ld_k) {
  const int pc = ((ld_k >> 3) ^ ((ld_row >> 1) & 7)) * 8;
  h16* w = sW + buf * 128 * GLS + ld_row * GLS + pc;
  h16* u = sU + buf * 128 * GLS + ld_row * GLS + pc;
  *(u32x4*)(w + 0 * 32 * GLS) = S.w0;
  *(u32x4*)(w + 1 * 32 * GLS) = S.w1;
  *(u32x4*)(w + 2 * 32 * GLS) = S.w2;
  *(u32x4*)(w + 3 * 32 * GLS) = S.w3;
  *(u32x4*)(u + 0 * 32 * GLS) = S.u0;
  *(u32x4*)(u + 1 * 32 * GLS) = S.u1;
  *(u32x4*)(u + 2 * 32 * GLS) = S.u2;
  *(u32x4*)(u + 3 * 32 * GLS) = S.u3;
}
__device__ __forceinline__ void g_compute(f32x4 (&acc)[4][4], const h16* cW, const h16* cU, int sw0) {
#pragma unroll
  for (int ks = 0; ks < 2; ++ks) {
    const int off = sw0 ^ (ks * 32);
    h16x8 a[4];
#pragma unroll
    for (int i = 0; i < 4; ++i) a[i] = *(const h16x8*)(cW + i * 16 * GLS + off);
    h16x8 bc = *(const h16x8*)(cU + off);
#pragma unroll
    for (int j = 0; j < 4; ++j) {
      h16x8 bn = bc;
      if (j < 3) bn = *(const h16x8*)(cU + (j + 1) * 16 * GLS + off);
      __builtin_amdgcn_sched_barrier(0);
#pragma unroll
      for (int i = 0; i < 4; ++i) acc[i][j] = mfma16(a[i], bc, acc[i][j]);
      __builtin_amdgcn_sched_barrier(0);
      bc = bn;
    }
  }
}
template <int EPI>
__device__ __forceinline__ void gemm_phase(const Params& P, int l, char* lds) {
  const int xcd = blockIdx.x & 7, lj = blockIdx.x >> 3;
  const int nchunk8 = (int)(gridDim.x >> 3);
  const h16* Wt = (EPI == 0) ? (const h16*)(P.ws + OFF_WTIN) + (size_t)l * NPAD * DM
                             : (const h16*)(P.ws + OFF_WTOUT) + (size_t)l * DM * DM;
  const h16* A = (const h16*)(P.ws + OFF_U);
  const int NTn = (EPI == 0) ? NPAD / 128 : DM / 128;
  const int ntiles = NTn * (MTOK / 128);
  h16* sW = (h16*)lds;
  h16* sU = sW + 2 * 128 * GLS;
  int tid = threadIdx.x;
  asm volatile("" : "+v"(tid));
  int lane = tid & 63, wave = tid >> 6;
  int wn = wave & 1, wm = wave >> 1;
  int lr = lane & 15, quad = lane >> 4;
  int ld_row = tid >> 3, ld_k = (tid & 7) * 8;
  const int sw0 = (quad ^ ((lr >> 1) & 7)) * 8;
  const int RN = (EPI == 0) ? 7 : 8;
  const int nrn = NTn / RN;
  for (int it = 0;; ++it) {
    int tile = (it * 8 + xcd) * nchunk8 + lj;
    if (tile >= ntiles) break;
    int rect = tile / (8 * RN), within = tile % (8 * RN);
    int mt = (rect / nrn) * 8 + (within & 7), nt = (rect % nrn) * RN + (within >> 3);
    int n0 = nt * 128, m0 = mt * 128;
    const h16* gW = Wt + (size_t)(n0 + ld_row) * DM + ld_k;
    const h16* gU = A + (size_t)(m0 + ld_row) * DM + ld_k;
    GStage stA, stB;
    f32x4 acc[4][4];
#pragma unroll
    for (int i = 0; i < 4; ++i)
#pragma unroll
      for (int j = 0; j < 4; ++j) acc[i][j] = (f32x4){0.f, 0.f, 0.f, 0.f};
    g_load(stB, gW, gU, 0);
    g_load(stA, gW, gU, 1);
    g_store(stB, sW, sU, 0, ld_row, ld_k);
    g_load(stB, gW, gU, 2);
    __syncthreads();
    for (int kt = 0; kt < 32; kt += 2) {
      g_store(stA, sW, sU, 1, ld_row, ld_k);
      __builtin_amdgcn_s_setprio(1);
      g_load(stA, gW, gU, min(kt + 3, 31));
      g_compute(acc, sW + (wn * 64 + lr) * GLS, sU + (wm * 64 + lr) * GLS, sw0);
      __builtin_amdgcn_s_setprio(0);
      __syncthreads();
      g_store(stB, sW, sU, 0, ld_row, ld_k);
      __builtin_amdgcn_s_setprio(1);
      g_load(stB, gW, gU, min(kt + 4, 31));
      g_compute(acc, sW + 128 * GLS + (wn * 64 + lr) * GLS, sU + 128 * GLS + (wm * 64 + lr) * GLS, sw0);
      __builtin_amdgcn_s_setprio(0);
      __syncthreads();
    }
    if (EPI == 0) {
      bool lat = (m0 >= MCTX);
      if (lat && n0 < C_VA) {
        const float2* rope = (const float2*)(P.ws + OFF_ROPE);
#pragma unroll
        for (int j = 0; j < 4; ++j) {
          int m = m0 + wm * 64 + j * 16 + lr;
          int t = (m - MCTX) & 1023;
#pragma unroll
          for (int i = 0; i < 2; ++i)
#pragma unroll
            for (int jj = 0; jj < 4; ++jj) {
              float2 cs = rope[t * 64 + wn * 32 + i * 16 + quad * 4 + jj];
              float x1 = acc[i][j][jj], x2 = acc[i + 2][j][jj];
              acc[i][j][jj] = x1 * cs.x - x2 * cs.y;
              acc[i + 2][j][jj] = x1 * cs.y + x2 * cs.x;
            }
        }
      }
      h16* proj = (h16*)(P.ws + OFF_PROJ);
#pragma unroll
      for (int i = 0; i < 4; ++i) {
        int n = n0 + wn * 64 + i * 16 + quad * 4;
        if (n >= DPROJ) continue;
        bool isVa = (n >= C_VA && n < C_GA);
        bool isVd = (n >= C_VD && n < C_GD);
#pragma unroll
        for (int j = 0; j < 4; ++j) {
          int m = m0 + wm * 64 + j * 16 + lr;
          f32x4 v = acc[i][j];
          if (isVa || isVd) {
            int nn = isVa ? n - C_VA : n - C_VD;
            h16* dst;
            int T, t;
            if (!lat) {
              int b = m >> 8; t = m & 255; T = 256;
              dst = isVa ? (h16*)(P.ws + OFF_VTA_CTX) + ((size_t)b * 256 + nn) * 256
                         : (h16*)(P.ws + OFF_VTD_CTX) + ((size_t)b * 512 + nn) * 256;
            } else {
              int b = (m - MCTX) >> 10; t = (m - MCTX) & 1023; T = 1024;
              dst = isVa ? (h16*)(P.ws + OFF_VTA_LAT) + ((size_t)b * 256 + nn) * 1024
                         : (h16*)(P.ws + OFF_VTD_LAT) + ((size_t)b * 512 + nn) * 1024;
            }
#pragma unroll
            for (int jj = 0; jj < 4; ++jj) dst[(size_t)jj * T + t] = (h16)v[jj];
          } else {
            *(h16x4*)(proj + (size_t)m * DPROJ + n) = pack4(v);
          }
          if (!lat) {
            int b = m >> 8, t = m & 255;
            size_t r = ((size_t)(b * 2 + l) * 256 + t);
            float* o = nullptr;
            if (n >= C_KA && n < C_VA) o = P.out + O_NAK + r * 256 + (n - C_KA);
            else if (isVa) o = P.out + O_NAV + r * 256 + (n - C_VA);
            else if (n >= C_KD && n < C_VD) o = P.out + O_NNK + r * 512 + (n - C_KD);
            else if (isVd) o = P.out + O_NNV + r * 512 + (n - C_VD);
            if (o) st_nt4(o, v[0], v[1], v[2], v[3]);
          }
        }
      }
    } else {
      const float alpha = 1.41421356237f;
      float* y = P.out + O_Y;
#pragma unroll
      for (int i = 0; i < 4; ++i) {
        int n = n0 + wn * 64 + i * 16 + quad * 4;
#pragma unroll
        for (int j = 0; j < 4; ++j) {
          int m = m0 + wm * 64 + j * 16 + lr;
          const float* xs;
          if (l == 0) xs = (m < MCTX) ? P.in[I_XP] + (size_t)m * DM : P.in[I_XS] + (size_t)(m - MCTX) * DM;
          else xs = y + (size_t)m * DM;
          float4 xv = *(const float4*)(xs + n);
          float4 g = *(const float4*)((const float*)(P.ws + OFF_MOD) + ((size_t)l * 5 + row_cond(m)) * 6144 + 4096 + n);
          f32x4 v = acc[i][j];
          float4 o = make_float4(alpha * xv.x + g.x * v[0], alpha * xv.y + g.y * v[1], alpha * xv.z + g.z * v[2],
                                 alpha * xv.w + g.w * v[3]);
          *(float4*)(y + (size_t)m * DM + n) = o;
        }
      }
    }
  }
}

struct JStage { u32x4 w0, w1, w2, w3, u0, u1, u2, u3, u4, u5, u6, u7; };
__device__ __forceinline__ u32x4 ldg_so(const h16* ubase, unsigned boff) {
  return *(const u32x4*)((const char*)ubase + boff);
}
__device__ __forceinline__ void j_load(JStage& S, const h16* Wk, const h16* Uk, unsigned voff) {
  S.w0 = ldg_so(Wk, voff + 0u * 131072u);
  S.w1 = ldg_so(Wk, voff + 1u * 131072u);
  S.w2 = ldg_so(Wk, voff + 2u * 131072u);
  S.w3 = ldg_so(Wk, voff + 3u * 131072u);
  S.u0 = ldg_so(Uk, voff + 0u * 131072u);
  S.u1 = ldg_so(Uk, voff + 1u * 131072u);
  S.u2 = ldg_so(Uk, voff + 2u * 131072u);
  S.u3 = ldg_so(Uk, voff + 3u * 131072u);
  S.u4 = ldg_so(Uk, voff + 4u * 131072u);
  S.u5 = ldg_so(Uk, voff + 5u * 131072u);
  S.u6 = ldg_so(Uk, voff + 6u * 131072u);
  S.u7 = ldg_so(Uk, voff + 7u * 131072u);
}
__device__ __forceinline__ void j_store(const JStage& S, h16* sW, h16* sU, int ld_row, int pc) {
  h16* w = sW + ld_row * 64 + pc;
  h16* u = sU + ld_row * 64 + pc;
  *(u32x4*)(w + 0 * 2048) = S.w0;
  *(u32x4*)(w + 1 * 2048) = S.w1;
  *(u32x4*)(w + 2 * 2048) = S.w2;
  *(u32x4*)(w + 3 * 2048) = S.w3;
  *(u32x4*)(u + 0 * 2048) = S.u0;
  *(u32x4*)(u + 1 * 2048) = S.u1;
  *(u32x4*)(u + 2 * 2048) = S.u2;
  *(u32x4*)(u + 3 * 2048) = S.u3;
  *(u32x4*)(u + 4 * 2048) = S.u4;
  *(u32x4*)(u + 5 * 2048) = S.u5;
  *(u32x4*)(u + 6 * 2048) = S.u6;
  *(u32x4*)(u + 7 * 2048) = S.u7;
}
__device__ __forceinline__ void j_compute(f32x4 (&acc)[4][8], const h16* cW, const h16* cU, int sw0) {
#pragma unroll
  for (int ks = 0; ks < 2; ++ks) {
    const int off = sw0 ^ (ks * 32);
    h16x8 a[4];
#pragma unroll
    for (int i = 0; i < 4; ++i) a[i] = *(const h16x8*)(cW + i * 16 * 64 + off);
    h16x8 b0 = *(const h16x8*)(cU + off);
    h16x8 b1 = *(const h16x8*)(cU + 1 * 16 * 64 + off);
#pragma unroll
    for (int j = 0; j < 8; ++j) {
      h16x8 b2 = b1;
      if (j < 6) b2 = *(const h16x8*)(cU + (j + 2) * 16 * 64 + off);
      __builtin_amdgcn_sched_barrier(0);
#pragma unroll
      for (int i = 0; i < 4; ++i) acc[i][j] = mfma16(a[i], b0, acc[i][j]);
      __builtin_amdgcn_sched_barrier(0);
      b0 = b1;
      b1 = b2;
    }
  }
}
__device__ __forceinline__ void gemm_in_phase(const Params& P, int l, char* lds) {
  const int xcd = blockIdx.x & 7, lj = blockIdx.x >> 3;
  const int nchunk8 = (int)(gridDim.x >> 3);
  const h16* Wt = (const h16*)(P.ws + OFF_WTIN) + (size_t)l * NPAD * DM;
  const h16* A = (const h16*)(P.ws + OFF_U);
  const int NTn = NPAD / 128;
  const int ntiles = NTn * (MTOK / 256);
  h16* sW = (h16*)lds;
  h16* sU = sW + 128 * 64;
  int tid = threadIdx.x;
  asm volatile("" : "+v"(tid));
  int lane = tid & 63, wave = tid >> 6;
  int wn = wave & 1, wm = wave >> 1;
  int lr = lane & 15, quad = lane >> 4;
  int ld_row = tid >> 3, ld_k = (tid & 7) * 8;
  const int pc = ((tid & 7) ^ ((ld_row >> 1) & 7)) * 8;
  const int sw0 = (quad ^ ((lr >> 1) & 7)) * 8;
  const int RN = 7, nrn = NTn / RN;
  for (int it = 0;; ++it) {
    int tile = (it * 8 + xcd) * nchunk8 + lj;
    if (tile >= ntiles) break;
    int rect = tile / (8 * RN), within = tile % (8 * RN);
    int mt = (rect / nrn) * 8 + (within & 7), nt = (rect % nrn) * RN + (within >> 3);
    int n0 = nt * 128, m0 = mt * 256;
    const h16* gW = Wt + (size_t)n0 * DM;
    const h16* gU = A + (size_t)m0 * DM;
    const unsigned voff = (unsigned)(ld_row * DM + ld_k) * 2u;
    JStage S;
    f32x4 acc[4][8];
#pragma unroll
    for (int i = 0; i < 4; ++i)
#pragma unroll
      for (int j = 0; j < 8; ++j) acc[i][j] = (f32x4){0.f, 0.f, 0.f, 0.f};
    j_load(S, gW, gU, voff);
    j_store(S, sW, sU, ld_row, pc);
    __syncthreads();
    const h16* cW = sW + (wn * 64 + lr) * 64;
    const h16* cU = sU + (wm * 128 + lr) * 64;
    for (int kt = 0; kt < 32; ++kt) {
      __builtin_amdgcn_s_setprio(1);
      { const int kn = min(kt + 1, 31) * 64; j_load(S, gW + kn, gU + kn, voff); }
      j_compute(acc, cW, cU, sw0);
      __builtin_amdgcn_s_setprio(0);
      __syncthreads();
      j_store(S, sW, sU, ld_row, pc);
      __syncthreads();
    }
    {
      bool lat = (m0 >= MCTX);
      if (lat && n0 < C_VA) {
        const float2* rope = (const float2*)(P.ws + OFF_ROPE);
#pragma unroll
        for (int j = 0; j < 8; ++j) {
          int m = m0 + wm * 128 + j * 16 + lr;
          int t = (m - MCTX) & 1023;
#pragma unroll
          for (int i = 0; i < 2; ++i)
#pragma unroll
            for (int jj = 0; jj < 4; ++jj) {
              float2 cs = rope[t * 64 + wn * 32 + i * 16 + quad * 4 + jj];
              float x1 = acc[i][j][jj], x2 = acc[i + 2][j][jj];
              acc[i][j][jj] = x1 * cs.x - x2 * cs.y;
              acc[i + 2][j][jj] = x1 * cs.y + x2 * cs.x;
            }
        }
      }
      h16* proj = (h16*)(P.ws + OFF_PROJ);
#pragma unroll
      for (int i = 0; i < 4; ++i) {
        int n = n0 + wn * 64 + i * 16 + quad * 4;
        if (n >= DPROJ) continue;
        bool isVa = (n >= C_VA && n < C_GA);
        bool isVd = (n >= C_VD && n < C_GD);
#pragma unroll
        for (int j = 0; j < 8; ++j) {
          int m = m0 + wm * 128 + j * 16 + lr;
          f32x4 v = acc[i][j];
          if (isVa || isVd) {
            int nn = isVa ? n - C_VA : n - C_VD;
            h16* dst;
            int T, t;
            if (!lat) {
              int b = m >> 8; t = m & 255; T = 256;
              dst = isVa ? (h16*)(P.ws + OFF_VTA_CTX) + ((size_t)b * 256 + nn) * 256
                         : (h16*)(P.ws + OFF_VTD_CTX) + ((size_t)b * 512 + nn) * 256;
            } else {
              int b = (m - MCTX) >> 10; t = (m - MCTX) & 1023; T = 1024;
              dst = isVa ? (h16*)(P.ws + OFF_VTA_LAT) + ((size_t)b * 256 + nn) * 1024
                         : (h16*)(P.ws + OFF_VTD_LAT) + ((size_t)b * 512 + nn) * 1024;
            }
#pragma unroll
            for (int jj = 0; jj < 4; ++jj) dst[(size_t)jj * T + t] = (h16)v[jj];
          } else {
            *(h16x4*)(proj + (size_t)m * DPROJ + n) = pack4(v);
          }
          if (!lat) {
            int b = m >> 8, t = m & 255;
            size_t r = ((size_t)(b * 2 + l) * 256 + t);
            float* o = nullptr;
            if (n >= C_KA && n < C_VA) o = P.out + O_NAK + r * 256 + (n - C_KA);
            else if (isVa) o = P.out + O_NAV + r * 256 + (n - C_VA);
            else if (n >= C_KD && n < C_VD) o = P.out + O_NNK + r * 512 + (n - C_KD);
            else if (isVd) o = P.out + O_NNV + r * 512 + (n - C_VD);
            if (o) st_nt4(o, v[0], v[1], v[2], v[3]);
          }
        }
      }
    }
  }
}

#define KLS 136
#define VLS 72
__device__ __forceinline__ void attn_unit(const Params& P, int l, int mode, int b, int h, int qt, char* lds) {
  h16* sK0 = (h16*)lds;
  h16* sVT0 = sK0 + 2 * 64 * KLS;
  float* sRpb = (float*)(sVT0 + 2 * 128 * VLS);
  int tid = threadIdx.x;
  asm volatile("" : "+v"(tid));
  int lane = tid & 63, wave = tid >> 6;
  int lr = lane & 15, quad = lane >> 4;
  const bool isA = (mode == 0 || mode == 2);
  const bool lat = (mode >= 2);
  const int T = lat ? 1024 : 256;
  const int rowbase = lat ? MCTX + b * 1024 : b * 256;
  const int qcol = isA ? C_QA : C_QD, kcol = isA ? C_KA : C_KD, gcol = isA ? C_GA : C_GD, ocol = isA ? 0 : 1536;
  const int nkv = isA ? 2 : 4;
  const int kvh = isA ? (h >> 1) : h;
  const h16* proj = (const h16*)(P.ws + OFF_PROJ);
  const h16* Kown = proj + (size_t)rowbase * DPROJ + kcol + kvh * 128;
  const h16* VTown = (const h16*)(P.ws + (isA ? (lat ? OFF_VTA_LAT : OFF_VTA_CTX) : (lat ? OFF_VTD_LAT : OFF_VTD_CTX))) +
                     ((size_t)(b * nkv + kvh) * 128) * T;
  const h16* Kc = (const h16*)(P.ws + (isA ? OFF_KCA : OFF_KCD)) + ((size_t)(b * 2 + l) * 256) * (nkv * 128) + kvh * 128;
  const h16* VTc = (const h16*)(P.ws + (isA ? OFF_VTAC : OFF_VTDC)) + ((size_t)((b * 2 + l) * nkv + kvh) * 128) * 256;
  const int q0 = qt * 64;
  int n0t, start0;
  if (mode < 2) { n0t = 4; start0 = 0; }
  else if (mode == 2) {
    int lo = q0 - 128; if (lo < 0) lo = 0;
    int hi = q0 + 192; if (hi > T) hi = T;
    start0 = lo; n0t = (hi - lo) >> 6;
  } else {
    int rs = qt - 4; if (rs < 0) rs = 0; if (rs > 8) rs = 8;
    start0 = rs * 64; n0t = 8;
  }
  const int ntot = n0t + (lat ? 4 : 0);
  __syncthreads();
  if (mode == 3) {
    const float* rpb = P.in[I_RPB] + ((size_t)l * 4 + h) * 15 * 31;
    for (int i = tid; i < 15 * 31; i += NTHREADS) sRpb[i] = rpb[i];
  }
  const int qi = wave * 16 + lr;
  const h16* qrow = proj + (size_t)(rowbase + q0 + qi) * DPROJ + qcol + h * 128 + quad * 8;
  h16x8 qf[4];
#pragma unroll
  for (int ks = 0; ks < 4; ++ks) qf[ks] = *(const h16x8*)(qrow + ks * 32);
  const float scale = 0.08838834764831845f;
  float m_run = -1e30f, l_run = 0.f;
  f32x4 O[8];
#pragma unroll
  for (int d = 0; d < 8; ++d) O[d] = (f32x4){0.f, 0.f, 0.f, 0.f};
  const int qpos = q0 + qi;
  const int qc = qi;
  int cs = qc - 8; if (cs < 0) cs = 0; if (cs > 48) cs = 48;

  u32x4 rk0, rk1, rk2, rk3, rv0, rv1, rv2, rv3;
  const int kr = tid >> 4, kch = (tid & 15) * 8;
  const int vr = tid >> 3, vch = (tid & 7) * 8;
#define ATT_LOAD(IT)                                                                              \
  {                                                                                               \
    const bool own_ = (IT) < n0t;                                                                 \
    const int ks_ = own_ ? start0 + (IT) * 64 : ((IT) - n0t) * 64;                                \
    const h16* Kp_ = own_ ? Kown + (size_t)ks_ * DPROJ : Kc + (size_t)ks_ * (nkv * 128);          \
    const size_t kst_ = own_ ? DPROJ : nkv * 128;                                                 \
    const h16* Vp_ = own_ ? VTown + ks_ : VTc + ks_;                                              \
    const size_t vst_ = own_ ? T : 256;                                                           \
    rk0 = *(const u32x4*)(Kp_ + (size_t)(kr) * kst_ + kch);                                       \
    rk1 = *(const u32x4*)(Kp_ + (size_t)(kr + 16) * kst_ + kch);                                  \
    rk2 = *(const u32x4*)(Kp_ + (size_t)(kr + 32) * kst_ + kch);                                  \
    rk3 = *(const u32x4*)(Kp_ + (size_t)(kr + 48) * kst_ + kch);                                  \
    rv0 = *(const u32x4*)(Vp_ + (size_t)(vr) * vst_ + vch);                                       \
    rv1 = *(const u32x4*)(Vp_ + (size_t)(vr + 32) * vst_ + vch);                                  \
    rv2 = *(const u32x4*)(Vp_ + (size_t)(vr + 64) * vst_ + vch);                                  \
    rv3 = *(const u32x4*)(Vp_ + (size_t)(vr + 96) * vst_ + vch);                                  \
  }
#define ATT_STORE(BUF)                                                        \
  {                                                                           \
    h16* k_ = sK0 + (BUF) * 64 * KLS + kr * KLS + kch;                        \
    h16* v_ = sVT0 + (BUF) * 128 * VLS + vr * VLS + vch;                      \
    *(u32x4*)(k_) = rk0; *(u32x4*)(k_ + 16 * KLS) = rk1;                      \
    *(u32x4*)(k_ + 32 * KLS) = rk2; *(u32x4*)(k_ + 48 * KLS) = rk3;           \
    *(u32x4*)(v_) = rv0; *(u32x4*)(v_ + 32 * VLS) = rv1;                      \
    *(u32x4*)(v_ + 64 * VLS) = rv2; *(u32x4*)(v_ + 96 * VLS) = rv3;           \
  }
  ATT_LOAD(0);
  ATT_STORE(0);
  if (ntot > 1) ATT_LOAD(1);
  __syncthreads();
  for (int it = 0; it < ntot; ++it) {
    const bool own = it < n0t;
    const int kstart = own ? start0 + it * 64 : (it - n0t) * 64;
    if (it + 1 < ntot) ATT_STORE((it + 1) & 1);
    if (it + 2 < ntot) ATT_LOAD(it + 2);
    const h16* sK = sK0 + (it & 1) * 64 * KLS;
    const h16* sVT = sVT0 + (it & 1) * 128 * VLS;
    f32x4 s[4];
#pragma unroll
    for (int kf = 0; kf < 4; ++kf) {
      s[kf] = (f32x4){0.f, 0.f, 0.f, 0.f};
#pragma unroll
      for (int ks = 0; ks < 4; ++ks) {
        h16x8 a = *(const h16x8*)(sK + (kf * 16 + lr) * KLS + ks * 32 + quad * 8);
        s[kf] = mfma16(a, qf[ks], s[kf]);
      }
    }
    float mx = -1e30f;
#pragma unroll
    for (int kf = 0; kf < 4; ++kf)
#pragma unroll
      for (int jj = 0; jj < 4; ++jj) {
        float v = s[kf][jj] * scale;
        int kk = kf * 16 + quad * 4 + jj;
        if (own && mode == 2) {
          int d = kstart + kk - qpos;
          if (d > 128 || d < -128) v = -1e30f;
        } else if (own && mode == 3) {
          if (kk >= cs && kk < cs + 16) {
            int dy = (kstart >> 6) - qt;
            int dx = kk - qc; if (dx < -15) dx = -15; if (dx > 15) dx = 15;
            v += sRpb[(dy + 7) * 31 + dx + 15];
          } else v = -1e30f;
        }
        s[kf][jj] = v;
        mx = fmaxf(mx, v);
      }
    mx = fmaxf(mx, __shfl_xor(mx, 16));
    mx = fmaxf(mx, __shfl_xor(mx, 32));
    float m_new = fmaxf(m_run, mx);
    float alpha = __expf(m_run - m_new);
    float psum = 0.f;
#pragma unroll
    for (int kf = 0; kf < 4; ++kf)
#pragma unroll
      for (int jj = 0; jj < 4; ++jj) {
        float p = __expf(s[kf][jj] - m_new);
        s[kf][jj] = p;
        psum += p;
      }
    l_run = l_run * alpha + psum;
    m_run = m_new;
#pragma unroll
    for (int d = 0; d < 8; ++d) { O[d][0] *= alpha; O[d][1] *= alpha; O[d][2] *= alpha; O[d][3] *= alpha; }
#pragma unroll
    for (int kk2 = 0; kk2 < 2; ++kk2) {
      h16x8 pb = pack8(s[2 * kk2], s[2 * kk2 + 1]);
#pragma unroll
      for (int d = 0; d < 8; ++d) {
        const h16* vr = sVT + (d * 16 + lr) * VLS + quad * 4;
        h16x8 a = read_split(vr + (2 * kk2) * 16, vr + (2 * kk2 + 1) * 16);
        O[d] = mfma16(a, pb, O[d]);
      }
    }
    __syncthreads();
  }
#undef ATT_LOAD
#undef ATT_STORE
  l_run += __shfl_xor(l_run, 16);
  l_run += __shfl_xor(l_run, 32);
  if (isA) l_run += __expf(P.in[I_SINK][l * 4 + h] - m_run);
  float inv = 1.f / l_run;
  const size_t row = (size_t)(rowbase + q0 + qi);
  const h16* grow = proj + row * DPROJ + gcol + h * 128;
  h16* orow = (h16*)(P.ws + OFF_U) + row * DM + ocol + h * 128;
#pragma unroll
  for (int d = 0; d < 8; ++d) {
    int dd = d * 16 + quad * 4;
    h16x4 g = *(const h16x4*)(grow + dd);
    h16x4 o;
#pragma unroll
    for (int jj = 0; jj < 4; ++jj) o[jj] = (h16)(O[d][jj] * inv * silu_f((float)g[jj]));
    *(h16x4*)(orow + dd) = o;
  }
}

__device__ __forceinline__ void conv_load(const Params& P, int l, int row0, int T, int t0, int ntok, int xcol, int ncols, h16* dst,
                          int dstride, bool transposed) {
  const h16* proj = (const h16*)(P.ws + OFF_PROJ);
  const float* cw = P.in[I_CONVW] + (size_t)l * 5 * 1024;
  const float* cb = P.in[I_CONVB] + (size_t)l * 1024;
  int tid0 = threadIdx.x;
  asm volatile("" : "+v"(tid0));
  int gpt = ncols >> 3;
  int total = ntok * gpt;
#pragma unroll 1
  for (int idx = tid0; idx < total; idx += NTHREADS) {
    int tl = idx / gpt, c = (idx % gpt) * 8;
    int t = t0 + tl;
    float acc[8];
    {
      float4 b0 = *(const float4*)(cb + xcol + c), b1 = *(const float4*)(cb + xcol + c + 4);
      acc[0] = b0.x; acc[1] = b0.y; acc[2] = b0.z; acc[3] = b0.w;
      acc[4] = b1.x; acc[5] = b1.y; acc[6] = b1.z; acc[7] = b1.w;
    }
#pragma unroll
    for (int k = 0; k < 5; ++k) {
      int tt = t + k - 2;
      if (tt >= 0 && tt < T) {
        h16x8 x = *(const h16x8*)(proj + (size_t)(row0 + tt) * DPROJ + C_XBC + xcol + c);
        float4 w0 = *(const float4*)(cw + k * 1024 + xcol + c), w1 = *(const float4*)(cw + k * 1024 + xcol + c + 4);
        acc[0] += w0.x * (float)x[0]; acc[1] += w0.y * (float)x[1]; acc[2] += w0.z * (float)x[2]; acc[3] += w0.w * (float)x[3];
        acc[4] += w1.x * (float)x[4]; acc[5] += w1.y * (float)x[5]; acc[6] += w1.z * (float)x[6]; acc[7] += w1.w * (float)x[7];
      }
    }
    h16x8 o;
#pragma unroll
    for (int e = 0; e < 8; ++e) o[e] = (h16)silu_f(acc[e]);
    if (!transposed) *(h16x8*)(dst + tl * dstride + c) = o;
    else {
#pragma unroll
      for (int e = 0; e < 8; ++e) dst[(c + e) * dstride + tl] = o[e];
    }
  }
}

__device__ __forceinline__ float softplus_f(float x) { return x > 20.f ? x : log1pf(__expf(x)); }

__device__ __forceinline__ void chunk_scan(const Params& P, int l, int row_chunk0, int dir, int h, int lane, float& dt0,
                                           float& dt1, float& L0, float& L1, int& tk0, int& tk1) {
  const h16* proj = (const h16*)(P.ws + OFF_PROJ);
  float bias = P.in[I_DTB][(l * 2 + dir) * 8 + h];
  float A = -__expf(P.in[I_ALOG][(l * 2 + dir) * 8 + h]);
  int e0 = 2 * lane, e1 = 2 * lane + 1;
  tk0 = dir ? 127 - e0 : e0;
  tk1 = dir ? 127 - e1 : e1;
  dt0 = softplus_f((float)proj[(size_t)(row_chunk0 + tk0) * DPROJ + C_DT + dir * 8 + h] + bias);
  dt1 = softplus_f((float)proj[(size_t)(row_chunk0 + tk1) * DPROJ + C_DT + dir * 8 + h] + bias);
  float a0 = dt0 * A, a1 = dt1 * A;
  float s = a0 + a1;
  float inc = s;
#pragma unroll
  for (int o = 1; o < 64; o <<= 1) {
    float v = __shfl_up(inc, o);
    if (lane >= o) inc += v;
  }
  float excl = inc - s;
  L0 = excl + a0;
  L1 = excl + a0 + a1;
}

#define TLS 1032
__device__ __forceinline__ void conv_unit(const Params& P, int l, int tile, char* lds) {
  int tid = threadIdx.x;
  asm volatile("" : "+v"(tid));
  const int rowt = tile * 32;
  const bool lat = rowt >= MCTX;
  const int T = lat ? 1024 : 256;
  const int row0 = lat ? MCTX + (((rowt - MCTX) >> 10) << 10) : (rowt >> 8) << 8;
  const int t0 = rowt - row0;
  h16* tileS = (h16*)lds;
  const h16* proj = (const h16*)(P.ws + OFF_PROJ);
  const int c = (tid & 127) * 8, half = tid >> 7;
  const float* cw = P.in[I_CONVW] + (size_t)l * 5 * 1024 + c;
  const float* cb = P.in[I_CONVB] + (size_t)l * 1024 + c;
  float w[5][8], bias[8];
#pragma unroll
  for (int k = 0; k < 5; ++k) {
    float4 a = *(const float4*)(cw + k * 1024), b4 = *(const float4*)(cw + k * 1024 + 4);
    w[k][0] = a.x; w[k][1] = a.y; w[k][2] = a.z; w[k][3] = a.w; w[k][4] = b4.x; w[k][5] = b4.y; w[k][6] = b4.z; w[k][7] = b4.w;
  }
  {
    float4 a = *(const float4*)cb, b4 = *(const float4*)(cb + 4);
    bias[0] = a.x; bias[1] = a.y; bias[2] = a.z; bias[3] = a.w; bias[4] = b4.x; bias[5] = b4.y; bias[6] = b4.z; bias[7] = b4.w;
  }
  __syncthreads();
#pragma unroll
  for (int part = 0; part < 2; ++part) {
    const int tb = t0 + half * 16 + part * 8;
    h16x8 xr[12];
#pragma unroll
    for (int r = 0; r < 12; ++r) {
      int tt = tb + r - 2;
      h16x8 z = {0, 0, 0, 0, 0, 0, 0, 0};
      xr[r] = (tt >= 0 && tt < T) ? *(const h16x8*)(proj + (size_t)(row0 + tt) * DPROJ + C_XBC + c) : z;
    }
#pragma unroll
    for (int i = 0; i < 8; ++i) {
      float acc[8];
#pragma unroll
      for (int e = 0; e < 8; ++e) acc[e] = bias[e];
#pragma unroll
      for (int k = 0; k < 5; ++k)
#pragma unroll
        for (int e = 0; e < 8; ++e) acc[e] += w[k][e] * (float)xr[i + k][e];
      h16x8 o;
#pragma unroll
      for (int e = 0; e < 8; ++e) o[e] = (h16)silu_f(acc[e]);
      *(h16x8*)(tileS + (half * 16 + part * 8 + i) * TLS + c) = o;
    }
  }
  __syncthreads();
  h16* xbcn = (h16*)(P.ws + OFF_XBCN);
#pragma unroll
  for (int i = 0; i < 8; ++i) {
    int idx = tid + i * 256;
    int r = idx >> 6, ch = (idx & 63) * 8;
    *(uint4*)(xbcn + (size_t)(rowt + r) * 512 + ch) = *(const uint4*)(tileS + r * TLS + 512 + ch);
  }
  h16* xt = (h16*)(P.ws + OFF_XT) + (size_t)row0 * 512 + t0;
  h16* bt = (h16*)(P.ws + OFF_BT) + (size_t)row0 * 256 + t0;
#pragma unroll
  for (int i = 0; i < 3; ++i) {
    int ch = tid + i * 256;
    h16* dst = (ch < 512) ? xt + (size_t)ch * T : bt + (size_t)(ch - 512) * T;
#pragma unroll
    for (int q = 0; q < 4; ++q) {
      h16x8 o;
#pragma unroll
      for (int e = 0; e < 8; ++e) o[e] = tileS[(q * 8 + e) * TLS + ch];
      *(h16x8*)(dst + q * 8) = o;
    }
  }
}

__device__ __forceinline__ void conv_phase(const Params& P, int l, char* lds) {
  const int U_CONV = 384, U_SCAN = 384;
  for (int u = blockIdx.x; u < U_CONV + U_SCAN; u += gridDim.x) {
    if (u < U_CONV) { conv_unit(P, l, u, lds); continue; }
    int tid = threadIdx.x;
    asm volatile("" : "+v"(tid));
    int lane = tid & 63, wave = tid >> 6;
    int wt = (u - U_CONV) * 4 + wave;
    int bc = wt >> 4, combo = wt & 15;
    int h = combo >> 1, dir = combo & 1;
    int rowc = (bc < 64) ? (bc >> 1) * 256 + (bc & 1) * 128 : MCTX + ((bc - 64) >> 3) * 1024 + ((bc - 64) & 7) * 128;
    float d0, d1, L0, L1; int k0, k1;
    chunk_scan(P, l, rowc, dir, h, lane, d0, d1, L0, L1, k0, k1);
    float* DT = (float*)(P.ws + OFF_DT) + (size_t)wt * 128;
    float* LL = (float*)(P.ws + OFF_LL) + (size_t)wt * 128;
    DT[k0] = d0; DT[k1] = d1; LL[k0] = L0; LL[k1] = L1;
    if (lane == 63) ((float*)(P.ws + OFF_CDEC))[wt] = __expf(L1);
  }
}

__device__ __forceinline__ void ssd_intra_unit(const Params& P, int l, bool lat, int b, int c, int h, char* lds) {
  const int T = lat ? 1024 : 256;
  const int row0 = lat ? MCTX + b * 1024 : b * 256;
  const int t0 = c * 128;
  const int bc = lat ? 64 + b * 8 + c : b * 2 + c;
  const int g = h >> 2;
  int tid = threadIdx.x;
  asm volatile("" : "+v"(tid));
  int lane = tid & 63, wave = tid >> 6;
  int lr = lane & 15, quad = lane >> 4;
  h16* sC = (h16*)lds;
  h16* sB = sC + 128 * KLS;
  float* fL = (float*)(lds + 69632);
  float* Lf = fL, *Lb = fL + 128, *dtf = fL + 256, *dtb = fL + 384, *wf = fL + 512, *wb = fL + 640;
  h16* sXT = (h16*)lds;
  h16* sBT = sXT + 64 * KLS;
  __syncthreads();
  const h16* xbcn = (const h16*)(P.ws + OFF_XBCN) + (size_t)(row0 + t0) * 512;
  u32x4 rc[8], rb[8];
#pragma unroll
  for (int i = 0; i < 8; ++i) {
    int idx = tid + i * 256;
    int r = idx >> 4, ch = (idx & 15) * 8;
    rc[i] = *(const u32x4*)(xbcn + (size_t)r * 512 + 256 + g * 128 + ch);
    rb[i] = *(const u32x4*)(xbcn + (size_t)r * 512 + g * 128 + ch);
  }
  if (tid < 128) {
    const float* DT = (const float*)(P.ws + OFF_DT) + (size_t)(bc * 16 + h * 2) * 128;
    const float* LL = (const float*)(P.ws + OFF_LL) + (size_t)(bc * 16 + h * 2) * 128;
    float lf = LL[tid], lb = LL[128 + tid], df = DT[tid], db = DT[128 + tid];
    float lfe = LL[127], lbe = LL[128];
    Lf[tid] = lf; Lb[tid] = lb; dtf[tid] = df; dtb[tid] = db;
    wf[tid] = __expf(lfe - lf) * df;
    wb[tid] = __expf(lbe - lb) * db;
  }
#pragma unroll
  for (int i = 0; i < 8; ++i) {
    int idx = tid + i * 256;
    int r = idx >> 4, ch = (idx & 15) * 8;
    *(u32x4*)(sC + r * KLS + ch) = rc[i];
    *(u32x4*)(sB + r * KLS + ch) = rb[i];
  }
  const h16* xtg = (const h16*)(P.ws + OFF_XT) + (size_t)row0 * 512 + (size_t)(h * 64) * T + t0;
  const h16* btg = (const h16*)(P.ws + OFF_BT) + (size_t)row0 * 256 + (size_t)(g * 128) * T + t0;
  u32x4 rx[4], rt[8];
#pragma unroll
  for (int i = 0; i < 4; ++i) {
    int idx = tid + i * 256;
    int r = idx >> 4, ch = (idx & 15) * 8;
    rx[i] = *(const u32x4*)(xtg + (size_t)r * T + ch);
  }
#pragma unroll
  for (int i = 0; i < 8; ++i) {
    int idx = tid + i * 256;
    int r = idx >> 4, ch = (idx & 15) * 8;
    rt[i] = *(const u32x4*)(btg + (size_t)r * T + ch);
  }
  __syncthreads();
  f32x4 acc[8][2];
#pragma unroll
  for (int jf = 0; jf < 8; ++jf) { acc[jf][0] = (f32x4){0.f, 0.f, 0.f, 0.f}; acc[jf][1] = (f32x4){0.f, 0.f, 0.f, 0.f}; }
#pragma unroll
  for (int ks = 0; ks < 4; ++ks) {
    h16x8 bo[2];
#pragma unroll
    for (int f = 0; f < 2; ++f) bo[f] = *(const h16x8*)(sC + (wave * 32 + f * 16 + lr) * KLS + ks * 32 + quad * 8);
#pragma unroll
    for (int jf = 0; jf < 8; ++jf) {
      h16x8 a = *(const h16x8*)(sB + (jf * 16 + lr) * KLS + ks * 32 + quad * 8);
      acc[jf][0] = mfma16(a, bo[0], acc[jf][0]);
      acc[jf][1] = mfma16(a, bo[1], acc[jf][1]);
    }
  }
  h16x8 mb[4][2];
  {
    const int i0 = wave * 32 + lr, i1 = wave * 32 + 16 + lr;
    const float Lfi0 = Lf[i0], Lbi0 = Lb[i0], Lfi1 = Lf[i1], Lbi1 = Lb[i1];
    const int dji = quad * 4 - i0;
#pragma unroll
    for (int kk = 0; kk < 4; ++kk) {
#pragma unroll
      for (int hf = 0; hf < 2; ++hf) {
        const int jf = 2 * kk + hf;
        const int jb = jf * 16 + quad * 4;
        f32x4 lfj = *(const f32x4*)(Lf + jb), lbj = *(const f32x4*)(Lb + jb);
        f32x4 dfj = *(const f32x4*)(dtf + jb), dbj = *(const f32x4*)(dtb + jb);
#pragma unroll
        for (int jj = 0; jj < 4; ++jj) {
          int t0_ = dji + jf * 16 + jj, t1_ = t0_ - 16;
          float mf0 = (float)((unsigned)(t0_ - 1) >> 31), mb0 = (float)((unsigned)(-t0_ - 1) >> 31);
          float mf1 = (float)((unsigned)(t1_ - 1) >> 31), mb1 = (float)((unsigned)(-t1_ - 1) >> 31);
          float w0 = mf0 * dfj[jj] * __expf(fminf(Lfi0 - lfj[jj], 0.f)) + mb0 * dbj[jj] * __expf(fminf(Lbi0 - lbj[jj], 0.f));
          float w1 = mf1 * dfj[jj] * __expf(fminf(Lfi1 - lfj[jj], 0.f)) + mb1 * dbj[jj] * __expf(fminf(Lbi1 - lbj[jj], 0.f));
          acc[jf][0][jj] *= w0;
          acc[jf][1][jj] *= w1;
        }
      }
      mb[kk][0] = pack8(acc[2 * kk][0], acc[2 * kk + 1][0]);
      mb[kk][1] = pack8(acc[2 * kk][1], acc[2 * kk + 1][1]);
      asm volatile("" : "+v"(mb[kk][0]), "+v"(mb[kk][1]));
      __builtin_amdgcn_sched_barrier(0);
    }
  }
  __syncthreads();
#pragma unroll
  for (int i = 0; i < 4; ++i) {
    int idx = tid + i * 256;
    int r = idx >> 4, ch = (idx & 15) * 8;
    *(u32x4*)(sXT + r * KLS + ch) = rx[i];
  }
#pragma unroll
  for (int i = 0; i < 8; ++i) {
    int idx = tid + i * 256;
    int r = idx >> 4, ch = (idx & 15) * 8;
    *(u32x4*)(sBT + r * KLS + ch) = rt[i];
  }
  __syncthreads();
  {
    f32x4 yacc[2][4];
#pragma unroll
    for (int f = 0; f < 2; ++f)
#pragma unroll
      for (int pf = 0; pf < 4; ++pf) yacc[f][pf] = (f32x4){0.f, 0.f, 0.f, 0.f};
#pragma unroll
    for (int kk = 0; kk < 4; ++kk) {
      h16x8 b0 = mb[kk][0];
      h16x8 b1 = mb[kk][1];
#pragma unroll
      for (int pf = 0; pf < 4; ++pf) {
        const h16* xr = sXT + (pf * 16 + lr) * KLS + quad * 4;
        h16x8 a = read_split(xr + (2 * kk) * 16, xr + (2 * kk + 1) * 16);
        yacc[0][pf] = mfma16(a, b0, yacc[0][pf]);
        yacc[1][pf] = mfma16(a, b1, yacc[1][pf]);
      }
      __builtin_amdgcn_sched_barrier(0);
    }
    float* ybuf = (float*)(P.ws + OFF_YBUF);
    const float Dh = P.in[I_SSMD][l * 8 + h];
#pragma unroll
    for (int f = 0; f < 2; ++f) {
      int i = wave * 32 + f * 16 + lr;
#pragma unroll
      for (int pf = 0; pf < 4; ++pf) {
        f32x4 v = yacc[f][pf];
#pragma unroll
        for (int jj = 0; jj < 4; ++jj) v[jj] += Dh * (float)sXT[(pf * 16 + quad * 4 + jj) * KLS + i];
        *(float4*)(ybuf + (size_t)(row0 + t0 + i) * 512 + h * 64 + pf * 16 + quad * 4) = make_float4(v[0], v[1], v[2], v[3]);
      }
    }
  }
#pragma unroll 1
  for (int dir = 0; dir < 2; ++dir) {
    const float* wx = dir ? wb : wf;
    int lr2 = lr;
    asm volatile("" : "+v"(lr2));
    f32x4 sacc[8];
#pragma unroll
    for (int nf = 0; nf < 8; ++nf) sacc[nf] = (f32x4){0.f, 0.f, 0.f, 0.f};
#pragma unroll
    for (int ks = 0; ks < 4; ++ks) {
      int j0 = ks * 32 + quad * 8;
      h16x8 x = *(const h16x8*)(sXT + (wave * 16 + lr2) * KLS + j0);
      f32x4 wa = *(const f32x4*)(wx + j0), wc = *(const f32x4*)(wx + j0 + 4);
      h16x8 xw;
#pragma unroll
      for (int e = 0; e < 4; ++e) {
        xw[e] = (h16)((float)x[e] * wa[e]);
        xw[e + 4] = (h16)((float)x[e + 4] * wc[e]);
      }
#pragma unroll
      for (int nf = 0; nf < 8; ++nf) {
        h16x8 a = *(const h16x8*)(sBT + (nf * 16 + lr2) * KLS + j0);
        sacc[nf] = mfma16(a, xw, sacc[nf]);
      }
    }
    h16* st = (h16*)(P.ws + OFF_STATES) + ((size_t)(bc * 8 + h) * 2 + dir) * 8192;
    int p = wave * 16 + lr;
#pragma unroll
    for (int nf = 0; nf < 8; ++nf) {
      int n = nf * 16 + quad * 4;
      *(h16x4*)(st + p * 128 + n) = pack4(sacc[nf]);
    }
  }
}

__device__ __forceinline__ void pool_unit(const Params& P, int l, int tile, int g, char* lds) {
  int rowt = tile * 64;
  bool lat = rowt >= MCTX;
  int T = lat ? 1024 : 256;
  int row0 = lat ? MCTX + (((rowt - MCTX) >> 10) << 10) : (rowt >> 8) << 8;
  int t0 = rowt - row0;
  int tid = threadIdx.x;
  asm volatile("" : "+v"(tid));
  int lane = tid & 63, wave = tid >> 6;
  int lr = lane & 15, quad = lane >> 4;
  h16* sP = (h16*)lds;
  h16* sA = sP + 80 * KLS;
  const h16* proj = (const h16*)(P.ws + OFF_PROJ);
  __syncthreads();
  for (int idx = tid; idx < 80 * 16; idx += NTHREADS) {
    int r = idx >> 4, c = (idx & 15) * 8;
    int tt = t0 - 8 + r;
    if (tt >= 0 && tt < T)
      *(uint4*)(sP + r * KLS + c) = *(const uint4*)(proj + (size_t)(row0 + tt) * DPROJ + C_PC + g * 128 + c);
  }
  __syncthreads();
  const int w = 2 << g;
  for (int idx = tid; idx < 64 * 16; idx += NTHREADS) {
    int tl = idx >> 4, c = (idx & 15) * 8;
    int t = t0 + tl;
    int lo = t - (w >> 1); if (lo < 0) lo = 0;
    int hi = t - (w >> 1) + w; if (hi > T) hi = T;
    float s[8];
#pragma unroll
    for (int e = 0; e < 8; ++e) s[e] = 0.f;
    for (int tt = lo; tt < hi; ++tt) {
      h16x8 x = *(const h16x8*)(sP + (tt - t0 + 8) * KLS + c);
#pragma unroll
      for (int e = 0; e < 8; ++e) s[e] += (float)x[e];
    }
    float invn = 1.f / (float)(hi - lo);
    h16x8 self = *(const h16x8*)(sP + (tl + 8) * KLS + c);
    h16x8 o;
#pragma unroll
    for (int e = 0; e < 8; ++e) o[e] = (h16)(s[e] * invn - (float)self[e]);
    *(h16x8*)(sA + tl * KLS + c) = o;
  }
  __syncthreads();
  const h16* WT = (const h16*)(P.ws + OFF_POOLWT) + (size_t)(l * 4 + g) * 128 * 128;
  f32x4 acc[8];
#pragma unroll
  for (int d = 0; d < 8; ++d) acc[d] = (f32x4){0.f, 0.f, 0.f, 0.f};
#pragma unroll
  for (int ks = 0; ks < 4; ++ks) {
    h16x8 bo = *(const h16x8*)(sA + (wave * 16 + lr) * KLS + ks * 32 + quad * 8);
#pragma unroll
    for (int d = 0; d < 8; ++d) {
      h16x8 a = *(const h16x8*)(WT + (d * 16 + lr) * 128 + ks * 32 + quad * 8);
      acc[d] = mfma16(a, bo, acc[d]);
    }
  }
  size_t row = (size_t)rowt + wave * 16 + lr;
  const float* pb = P.in[I_POOLB] + (l * 4 + g) * 128;
  const float* ps = P.in[I_POOLS] + l * 512 + g * 128;
  const h16* grow = proj + row * DPROJ + C_GC + g * 128;
  h16* orow = (h16*)(P.ws + OFF_U) + row * DM + 1024 + g * 128;
#pragma unroll
  for (int d = 0; d < 8; ++d) {
    int dd = d * 16 + quad * 4;
    float4 b4 = *(const float4*)(pb + dd), s4 = *(const float4*)(ps + dd);
    h16x4 gt = *(const h16x4*)(grow + dd);
    h16x4 o;
    o[0] = (h16)((acc[d][0] + b4.x) * s4.x * silu_f((float)gt[0]));
    o[1] = (h16)((acc[d][1] + b4.y) * s4.y * silu_f((float)gt[1]));
    o[2] = (h16)((acc[d][2] + b4.z) * s4.z * silu_f((float)gt[2]));
    o[3] = (h16)((acc[d][3] + b4.w) * s4.w * silu_f((float)gt[3]));
    *(h16x4*)(orow + dd) = o;
  }
}

__device__ __forceinline__ void mix1_phase(const Params& P, int l, char* lds) {
  const int U_LD = 256, U_LA = 256, U_SSL = 256, U_SSC = 512, U_CA = 512, U_CD = 512, U_POOL = 768;
  const int total = U_LD + U_LA + U_SSL + U_SSC + U_CA + U_CD + U_POOL;
  for (int u = blockIdx.x; u < total; u += gridDim.x) {
    int v = u;
    if (v < U_LD) { attn_unit(P, l, 3, v >> 6, (v >> 4) & 3, v & 15, lds); continue; }
    v -= U_LD;
    if (v < U_LA) { attn_unit(P, l, 2, v >> 6, (v >> 4) & 3, v & 15, lds); continue; }
    v -= U_LA;
    if (v < U_SSL) { ssd_intra_unit(P, l, true, v >> 6, (v >> 3) & 7, v & 7, lds); continue; }
    v -= U_SSL;
    if (v < U_SSC) { ssd_intra_unit(P, l, false, v >> 4, (v >> 3) & 1, v & 7, lds); continue; }
    v -= U_SSC;
    if (v < U_CA) { attn_unit(P, l, 0, v >> 4, (v >> 2) & 3, v & 3, lds); continue; }
    v -= U_CA;
    if (v < U_CD) { attn_unit(P, l, 1, v >> 4, (v >> 2) & 3, v & 3, lds); continue; }
    v -= U_CD;
    pool_unit(P, l, v >> 2, v & 3, lds);
  }
}

__device__ __forceinline__ h16x8 hstart_frag(const Params& P, int l, bool lat, int b, int c, int h, int dir, int p, int n) {
  if (!lat) {
    bool zero = (dir == 0) ? (c == 0) : (c == 1);
    h16x8 z = {0, 0, 0, 0, 0, 0, 0, 0};
    if (zero) return z;
    int bc = b * 2 + (dir == 0 ? 0 : 1);
    return *(const h16x8*)((const h16*)(P.ws + OFF_STATES) + ((size_t)(bc * 8 + h) * 2 + dir) * 8192 + p * 128 + n);
  }
  return *(const h16x8*)((const h16*)(P.ws + OFF_HS) + ((size_t)(((b * 8 + c) * 8 + h) * 2 + dir)) * 8192 + p * 128 + n);
}

#define CLS 264
#define XLS 520
__device__ __forceinline__ void ssd_inter_unit(const Params& P, int l, bool lat, int b, int c, int sub, char* lds) {
  const int T = lat ? 1024 : 256;
  const int row0 = lat ? MCTX + b * 1024 : b * 256;
  const int tc0 = c * 128;
  const int t0 = tc0 + sub * 32;
  int tid = threadIdx.x;
  asm volatile("" : "+v"(tid));
  int lane = tid & 63, wave = tid >> 6;
  int lr = lane & 15, quad = lane >> 4;
  h16* sC = (h16*)lds;
  h16* sX = sC + 32 * CLS;
  float* eL = (float*)(lds + 50176);
  float* sred = eL + 16 * 32;
  const h16* proj = (const h16*)(P.ws + OFF_PROJ);
  __syncthreads();
  const int bc = lat ? 64 + b * 8 + c : b * 2 + c;
  {
    const float* LL = (const float*)(P.ws + OFF_LL) + (size_t)bc * 16 * 128 + sub * 32;
#pragma unroll
    for (int i = 0; i < 2; ++i) {
      int idx = tid + i * 256;
      int combo = idx >> 5, r = idx & 31;
      eL[combo * 32 + r] = __expf(LL[combo * 128 + r]);
    }
    const h16* xbcn = (const h16*)(P.ws + OFF_XBCN) + (size_t)(row0 + t0) * 512 + 256;
#pragma unroll
    for (int i = 0; i < 4; ++i) {
      int idx = tid + i * 256;
      int r = idx >> 5, ch = (idx & 31) * 8;
      *(uint4*)(sC + r * CLS + ch) = *(const uint4*)(xbcn + (size_t)r * 512 + ch);
    }
  }
  __syncthreads();
  float ssq[2] = {0.f, 0.f};
  const float* ybuf = (const float*)(P.ws + OFF_YBUF);
#pragma unroll 1
  for (int hh = 0; hh < 2; ++hh) {
    const int h = wave * 2 + hh;
    const int g = h >> 2;
    float vals[4][2][4];
#pragma unroll
    for (int pf = 0; pf < 4; ++pf)
#pragma unroll
      for (int f = 0; f < 2; ++f)
#pragma unroll
        for (int jj = 0; jj < 4; ++jj) vals[pf][f][jj] = 0.f;
#pragma unroll 1
    for (int dir = 0; dir < 2; ++dir) {
      f32x4 acc[4][2];
#pragma unroll
      for (int pf = 0; pf < 4; ++pf) { acc[pf][0] = (f32x4){0.f, 0.f, 0.f, 0.f}; acc[pf][1] = (f32x4){0.f, 0.f, 0.f, 0.f}; }
#pragma unroll
      for (int ks = 0; ks < 4; ++ks) {
        h16x8 b0 = *(const h16x8*)(sC + (lr)*CLS + g * 128 + ks * 32 + quad * 8);
        h16x8 b1 = *(const h16x8*)(sC + (16 + lr) * CLS + g * 128 + ks * 32 + quad * 8);
#pragma unroll
        for (int pf = 0; pf < 4; ++pf) {
          h16x8 a = hstart_frag(P, l, lat, b, c, h, dir, pf * 16 + lr, ks * 32 + quad * 8);
          acc[pf][0] = mfma16(a, b0, acc[pf][0]);
          acc[pf][1] = mfma16(a, b1, acc[pf][1]);
        }
      }
      float e0 = eL[(h * 2 + dir) * 32 + lr], e1 = eL[(h * 2 + dir) * 32 + 16 + lr];
#pragma unroll
      for (int pf = 0; pf < 4; ++pf)
#pragma unroll
        for (int jj = 0; jj < 4; ++jj) {
          vals[pf][0][jj] += e0 * acc[pf][0][jj];
          vals[pf][1][jj] += e1 * acc[pf][1][jj];
        }
    }
#pragma unroll
    for (int f = 0; f < 2; ++f) {
      int il = f * 16 + lr;
      size_t row = (size_t)(row0 + t0 + il);
#pragma unroll
      for (int pf = 0; pf < 4; ++pf) {
        int ch = h * 64 + pf * 16 + quad * 4;
        float4 yi = *(const float4*)(ybuf + row * 512 + ch);
        h16x4 zv = *(const h16x4*)(proj + row * DPROJ + C_Z + ch);
        float y0 = vals[pf][f][0] + yi.x;
        float y1 = vals[pf][f][1] + yi.y;
        float y2 = vals[pf][f][2] + yi.z;
        float y3 = vals[pf][f][3] + yi.w;
        y0 *= silu_f((float)zv[0]); y1 *= silu_f((float)zv[1]); y2 *= silu_f((float)zv[2]); y3 *= silu_f((float)zv[3]);
        ssq[f] += y0 * y0 + y1 * y1 + y2 * y2 + y3 * y3;
        h16x4 o;
        o[0] = (h16)y0; o[1] = (h16)y1; o[2] = (h16)y2; o[3] = (h16)y3;
        *(h16x4*)(sX + il * XLS + ch) = o;
      }
    }
  }
#pragma unroll
  for (int f = 0; f < 2; ++f) {
    ssq[f] += __shfl_xor(ssq[f], 16);
    ssq[f] += __shfl_xor(ssq[f], 32);
    if (quad == 0) sred[wave * 32 + f * 16 + lr] = ssq[f];
  }
  __syncthreads();
  const float* nw = P.in[I_NORMW] + l * 512;
  h16* mixed = (h16*)(P.ws + OFF_U);
#pragma unroll
  for (int f = 0; f < 2; ++f) {
    int il = f * 16 + lr;
    float tot = sred[il] + sred[32 + il] + sred[64 + il] + sred[96 + il];
    float rstd = rsqrtf(tot * (1.f / 512.f) + 1e-6f);
    size_t row = (size_t)(row0 + t0 + il);
#pragma unroll 1
    for (int hh = 0; hh < 2; ++hh) {
      int h = wave * 2 + hh;
#pragma unroll
      for (int pf = 0; pf < 4; ++pf) {
        int ch = h * 64 + pf * 16 + quad * 4;
        float4 w4 = *(const float4*)(nw + ch);
        h16x4 yv = *(const h16x4*)(sX + il * XLS + ch);
        h16x4 o;
        o[0] = (h16)((float)yv[0] * rstd * w4.x);
        o[1] = (h16)((float)yv[1] * rstd * w4.y);
        o[2] = (h16)((float)yv[2] * rstd * w4.z);
        o[3] = (h16)((float)yv[3] * rstd * w4.w);
        *(h16x4*)(mixed + row * DM + 512 + ch) = o;
      }
    }
  }
}

__device__ __forceinline__ void scan_phase(const Params& P, int l) {
  const int U_LAT = 512, U_FIN = 512;
  const float* h0f_ = P.in[I_SF];
  const float* h0b_ = P.in[I_SB];
  asm volatile("" : "+v"(h0f_), "+v"(h0b_));
  int tid = threadIdx.x;
  asm volatile("" : "+v"(tid));
  const h16* st = (const h16*)(P.ws + OFF_STATES);
  const float* cd = (const float*)(P.ws + OFF_CDEC);
  for (int u = blockIdx.x; u < U_LAT + U_FIN; u += gridDim.x) {
    if (u < U_LAT) {
      int sl = u & 7, dir = (u >> 3) & 1, h = (u >> 4) & 7, b = u >> 7;
      int idx = sl * 1024 + tid * 4;
      float4 hv = *(const float4*)((dir == 0 ? h0f_ : h0b_) + ((size_t)((b * 2 + l) * 8 + h)) * 8192 + idx);
      h16x4 sv[8];
      float dc[8];
#pragma unroll
      for (int s_ = 0; s_ < 8; ++s_) {
        int cc = (dir == 0) ? s_ : 7 - s_;
        int bc = 64 + b * 8 + cc;
        sv[s_] = *(const h16x4*)(st + ((size_t)(bc * 8 + h) * 2 + dir) * 8192 + idx);
        dc[s_] = cd[(bc * 8 + h) * 2 + dir];
      }
      h16* hs = (h16*)(P.ws + OFF_HS);
#pragma unroll
      for (int s_ = 0; s_ < 8; ++s_) {
        int cc = (dir == 0) ? s_ : 7 - s_;
        h16x4 o;
        o[0] = (h16)hv.x; o[1] = (h16)hv.y; o[2] = (h16)hv.z; o[3] = (h16)hv.w;
        *(h16x4*)(hs + ((size_t)(((b * 8 + cc) * 8 + h) * 2 + dir)) * 8192 + idx) = o;
        hv.x = dc[s_] * hv.x + (float)sv[s_][0]; hv.y = dc[s_] * hv.y + (float)sv[s_][1];
        hv.z = dc[s_] * hv.z + (float)sv[s_][2]; hv.w = dc[s_] * hv.w + (float)sv[s_][3];
      }
    } else {
      int v = u - U_LAT;
      int dir = v & 1, h = (v >> 1) & 7, b = v >> 4;
      int cfirst = dir == 0 ? 0 : 1, clast = dir == 0 ? 1 : 0;
      int bcf = b * 2 + cfirst, bcl = b * 2 + clast;
      float dcy = cd[(bcl * 8 + h) * 2 + dir];
      const h16* s0 = st + ((size_t)(bcf * 8 + h) * 2 + dir) * 8192;
      const h16* s1 = st + ((size_t)(bcl * 8 + h) * 2 + dir) * 8192;
      float* o = P.out + (dir == 0 ? O_SF : O_SB) + ((size_t)((b * 2 + l) * 8 + h)) * 8192;
#pragma unroll
      for (int i = 0; i < 8; ++i) {
        int idx = (i * 256 + tid) * 4;
        h16x4 a = *(const h16x4*)(s0 + idx), c4 = *(const h16x4*)(s1 + idx);
        *(float4*)(o + idx) = make_float4(dcy * (float)a[0] + (float)c4[0], dcy * (float)a[1] + (float)c4[1],
                                          dcy * (float)a[2] + (float)c4[2], dcy * (float)a[3] + (float)c4[3]);
      }
    }
  }
}

__device__ __forceinline__ void mix2_phase(const Params& P, int l, char* lds) {
  const int U_LAT = 128, U_CTX = 256;
  for (int u = blockIdx.x; u < U_LAT + U_CTX; u += gridDim.x) {
    int v = u;
    if (v < U_LAT) { ssd_inter_unit(P, l, true, v >> 5, (v >> 2) & 7, v & 3, lds); continue; }
    v -= U_LAT;
    ssd_inter_unit(P, l, false, v >> 3, (v >> 2) & 1, v & 3, lds);
  }
}

#define XB_TMO      128
#define XB_XCNT(j)  (256  + 64 * (j))
#define XB_XSUB(j)  (1280 + 64 * (j))
#define XB_XGEN(j)  (2304 + 64 * (j))
#define XB_TOP      3328
#define XB_TOPGEN   3392
#define XCD_BAR_WORDS 3456
#define XB_SPIN_CAP (1u << 18)
#define LAS __attribute__((address_space(3)))
__device__ __forceinline__ unsigned xb_ld(unsigned* p)              { return __hip_atomic_load(p, __ATOMIC_RELAXED, __HIP_MEMORY_SCOPE_AGENT); }
__device__ __forceinline__ unsigned xb_add(unsigned* p, unsigned v) { return __hip_atomic_fetch_add(p, v, __ATOMIC_RELAXED, __HIP_MEMORY_SCOPE_AGENT); }
__device__ __forceinline__ unsigned xb_xcc_id() { return (unsigned)__builtin_amdgcn_s_getreg((3 << 11) | 20) & 0xFu; }
#define XB_SPIN(cond, bar) do { unsigned _sp = 0; while (cond) { __builtin_amdgcn_s_sleep(1); \
    if ((++_sp & 255u) == 0u) { if (xb_ld(&(bar)[XB_TMO])) break; if (_sp > XB_SPIN_CAP) { atomicAdd(&(bar)[XB_TMO], 1u); break; } } } } while (0)
struct XcdBarrier { unsigned* bar; unsigned x; volatile LAS unsigned* st; };
__device__ __forceinline__ XcdBarrier xcd_barrier_post(unsigned* bar, volatile LAS unsigned* st) {
    XcdBarrier b; b.bar = bar; b.x = xb_xcc_id(); b.st = st;
    if (threadIdx.x == 0) (void)xb_add(&bar[XB_XCNT(b.x)], 1u);
    return b;
}
__device__ __forceinline__ void xcd_barrier_complete(unsigned* bar, unsigned x, unsigned& nloc, unsigned& nx) {
    const unsigned G = gridDim.x * gridDim.y * gridDim.z;
    unsigned sum, cnt, mine, sp = 0u;
    for (;;) {
        sum = 0u; cnt = 0u; mine = 0u;
#pragma unroll
        for (unsigned j = 0; j < 16; ++j) { const unsigned c = xb_ld(&bar[XB_XCNT(j)]); sum += c; cnt += (c > 0u) ? 1u : 0u; mine = (j == x) ? c : mine; }
        if (sum == G) break;
        __builtin_amdgcn_s_sleep(1);
        if ((++sp & 255u) == 0u) { if (xb_ld(&bar[XB_TMO])) break; if (sp > XB_SPIN_CAP) { atomicAdd(&bar[XB_TMO], 1u); break; } }
    }
    nloc = mine > 0u ? mine : 1u; nx = cnt > 0u ? cnt : 1u;
}
__device__ __forceinline__ void xcd_barrier(const XcdBarrier& b) {
    asm volatile("s_waitcnt vmcnt(0)" ::: "memory");
    __syncthreads();
    if (threadIdx.x == 0) {
        unsigned* bar = b.bar;
        asm volatile("" : "+v"(bar));
        __builtin_amdgcn_s_waitcnt(0);
        unsigned nloc = b.st[0], nx = b.st[1];
        if (nloc == 0u) { xcd_barrier_complete(bar, b.x, nloc, nx); b.st[0] = nloc; b.st[1] = nx; }
        const unsigned old = xb_add(&bar[XB_XSUB(b.x)], 1u);
        const unsigned gen = old / nloc;
        if (old + 1u == (gen + 1u) * nloc) {
            __builtin_amdgcn_fence(__ATOMIC_RELEASE, "agent");
            asm volatile("s_waitcnt vmcnt(0)" ::: "memory");
            const unsigned og = xb_add(&bar[XB_TOP], 1u);
            const unsigned tg = og / nx;
            if (og + 1u == (tg + 1u) * nx) xb_add(&bar[XB_TOPGEN], 1u);
            else XB_SPIN(xb_ld(&bar[XB_TOPGEN]) == tg, bar);
            __builtin_amdgcn_fence(__ATOMIC_ACQUIRE, "agent");
            xb_add(&bar[XB_XGEN(b.x)], 1u);
            asm volatile("s_waitcnt vmcnt(0)" ::: "memory");
        } else {
            XB_SPIN(xb_ld(&bar[XB_XGEN(b.x)]) == gen, bar);
            __builtin_amdgcn_fence(__ATOMIC_ACQUIRE, "agent");
            asm volatile("s_waitcnt vmcnt(0)" ::: "memory");
        }
    }
    __syncthreads();
}

__global__ void __launch_bounds__(NTHREADS, 2) mega_kernel(Params P) {
  __shared__ __attribute__((aligned(16))) char lds[LDS_BYTES];
  __shared__ uint4 xb_words;
  cg::grid_group grid = cg::this_grid();
  if (P.phase_lo < 0) grid.sync();
  if (threadIdx.x == 0) xb_words = make_uint4(0u, 0u, 0u, 0u);
  __syncthreads();
  XcdBarrier xb = xcd_barrier_post((unsigned*)(P.ws + OFF_BAR), (volatile LAS unsigned*)&xb_words);
  for (int ph = P.phase_lo; ph < P.phase_hi; ++ph) {
    const int l = (ph == 0) ? 0 : (ph - 1) / 7;
    const int k = (ph == 0) ? -1 : (ph == 15 ? 0 : (ph - 1) % 7);
    switch (k) {
      case -1: prep_phase(P, lds); break;
      case 0: if (ph == 1) prep_rest_phase(P, lds); row_phase(P, l); break;
      case 1: gemm_in_phase(P, l, lds); break;
      case 2: conv_phase(P, l, lds); break;
      case 3: mix1_phase(P, l, lds); break;
      case 4: scan_phase(P, l); break;
      case 5: mix2_phase(P, l, lds); break;
      default: gemm_phase<1>(P, l, lds); break;
    }
    if (ph + 1 < P.phase_hi) xcd_barrier(xb);
  }
}

#ifndef MK_MULTI
#define MK_MULTI 0
#endif

extern "C" void kernel_launch(void* const* d_in, const int* in_sizes, int n_in, void* d_out, int out_size, void* d_ws,
                              size_t ws_size, hipStream_t stream) {
  if (ws_size < WS_NEED) {
    fprintf(stderr, "workspace too small: %zu < %zu\n", ws_size, (size_t)WS_NEED);
    return;
  }
  static int grid_blocks = 0;
  if (!grid_blocks) {
    int dev = 0, cus = 0, per_cu = 0;
    hipGetDevice(&dev);
    hipDeviceGetAttribute(&cus, hipDeviceAttributeMultiprocessorCount, dev);
    hipOccupancyMaxActiveBlocksPerMultiprocessor(&per_cu, mega_kernel, NTHREADS, 0);
    if (per_cu > 2) per_cu = 2;
    if (per_cu < 1) per_cu = 1;
    grid_blocks = cus * per_cu;
  }
  Params p{};
  for (int i = 0; i < 27; ++i) p.in[i] = (const float*)d_in[i];
  p.out = (float*)d_out;
  p.ws = (char*)d_ws;
  hipMemsetAsync((char*)d_ws + OFF_MOD, 0, SZ_MOD + SZ_BAR, stream);
#if MK_MULTI
  for (int ph = 0; ph < 16; ++ph) {
    p.phase_lo = ph; p.phase_hi = ph + 1;
    hipLaunchKernelGGL(mega_kernel, dim3(grid_blocks), dim3(NTHREADS), 0, stream, p);
  }
#else
  p.phase_lo = 0; p.phase_hi = 16;
  void* args[] = {&p};
  hipError_t e = hipLaunchCooperativeKernel((void*)mega_kernel, dim3(grid_blocks), dim3(NTHREADS), args, 0, stream);
  if (e != hipSuccess) fprintf(stderr, "cooperative launch failed: %s (grid %d)\n", hipGetErrorString(e), grid_blocks);
#endif
}
```
